# Optimizing an MI355X kernel written in HIP

```python
import math
import jax, jax.numpy as jnp
from jax import lax
import numpy as np

D_MODEL = 1024
BATCH = 8
SEQ = 4096
DEPTH = 1

NSA_HEADS = 8
NSA_KV_HEADS = 2
NSA_GROUP = NSA_HEADS // NSA_KV_HEADS
HEAD_DIM = 64
CMP_LEN = 32
CMP_STRIDE = 16
CMP_HIDDEN = 64
SLC_BLOCK = 64
SLC_TOPN = 16
WINDOW = 512
Q_CHUNK = 64
FORCED_BONUS = 1.0e4
DN_HEADS = 8
DN_KDIM = 64
DN_VDIM = 64
DN_CONV = 4
DN_CHUNK = 64
DT_MIN = 0.001
DT_MAX = 0.1
PEER_HEADS = 8
PEER_NKEYS = 128
PEER_EXPERTS = PEER_NKEYS * PEER_NKEYS
PEER_DKEY = 128
PEER_HALF = PEER_DKEY // 2
PEER_TOPK = 16
PEER_TOK_CHUNK = 128
REL_BUCKETS = 32
REL_MAX_DIST = 128
EPS = 1e-6
NEG_INF = -1e30

NSA_Q_W = NSA_HEADS * HEAD_DIM
NSA_KV_W = NSA_KV_HEADS * HEAD_DIM
DN_QK_W = DN_HEADS * DN_KDIM
DN_V_W = DN_HEADS * DN_VDIM
DN_CONV_W = 2 * DN_QK_W + DN_V_W
IN_SPLIT_SIZES = (NSA_Q_W, NSA_KV_W, NSA_KV_W, NSA_KV_W, NSA_KV_W, NSA_KV_W, NSA_KV_W, NSA_HEADS * 3, DN_QK_W, DN_QK_W, DN_V_W, DN_V_W, DN_HEADS, DN_HEADS, D_MODEL, D_MODEL)
IN_COLS = sum(IN_SPLIT_SIZES)
IN_SPLIT_POINTS = tuple(int(v) for v in np.cumsum(IN_SPLIT_SIZES)[:-1])

kernel_name = 'hybrid_nsa_gdn_peer_block'


def rms_norm(x, g):
    xf = x.astype(jnp.float32)
    y = xf * lax.rsqrt(jnp.mean(xf * xf, axis=-1, keepdims=True) + EPS)
    return (y * g.astype(jnp.float32)).astype(x.dtype)


def l2_normalize(x):
    xf = x.astype(jnp.float32)
    return (xf * lax.rsqrt(jnp.sum(xf * xf, axis=-1, keepdims=True) + EPS)).astype(x.dtype)


def masked_softmax(logits, mask):
    l = jnp.where(mask, logits.astype(jnp.float32), NEG_INF)
    m = jnp.max(l, axis=-1, keepdims=True)
    e = jnp.where(mask, jnp.exp(l - m), 0.0)
    return e / jnp.maximum(jnp.sum(e, axis=-1, keepdims=True), 1e-30)


def rel_bucket(dist):
    dist = jnp.maximum(dist, 0)
    max_exact = REL_BUCKETS // 2
    scaled = jnp.log(jnp.maximum(dist, 1).astype(jnp.float32) / max_exact) / math.log(REL_MAX_DIST / max_exact)
    large = jnp.minimum(max_exact + (scaled * (REL_BUCKETS - max_exact)).astype(jnp.int32), REL_BUCKETS - 1)
    return jnp.where(dist < max_exact, dist, large)


def causal_depthwise_conv(x, w):
    return lax.conv_general_dilated(x, w[:, None, :].astype(x.dtype), (1,), [(DN_CONV - 1, 0)], dimension_numbers=('NWC', 'WIO', 'NWC'), feature_group_count=x.shape[-1])


def compress_blocks(kv, blk_idx, pos_emb, w1, w2):
    B = kv.shape[0]
    n_cmp = blk_idx.shape[0]
    blk = kv[:, blk_idx] + pos_emb[None, None, :, None, :]
    blk = blk.transpose(0, 1, 3, 2, 4).reshape(B, n_cmp, NSA_KV_HEADS, CMP_LEN * HEAD_DIM)
    return jnp.einsum('bnhe,ed->bhnd', jax.nn.gelu(blk @ w1), w2)


def nsa_attention(q, k_cmp, v_cmp, k_slc, v_slc, k_win, v_win, gate_logits, rel_bias, cmp_pos_emb, w_ck1, w_ck2, w_cv1, w_cv2):
    B, S, _ = q.shape
    KV, G, DH = NSA_KV_HEADS, NSA_GROUP, HEAD_DIM
    q = q.reshape(B, S, KV, G, DH) * (DH ** -0.5)
    k_cmp, v_cmp, k_slc, v_slc, k_win, v_win = (t.reshape(B, S, KV, DH) for t in (k_cmp, v_cmp, k_slc, v_slc, k_win, v_win))
    dist_bias = rel_bias[rel_bucket(jnp.arange(S))].T.reshape(KV, G, S)
    n_cmp = (S - CMP_LEN) // CMP_STRIDE + 1
    cmp_start = jnp.arange(n_cmp) * CMP_STRIDE
    cmp_end = cmp_start + CMP_LEN - 1
    blk_idx = cmp_start[:, None] + jnp.arange(CMP_LEN)[None, :]
    kc = compress_blocks(k_cmp, blk_idx, cmp_pos_emb, w_ck1, w_ck2)
    vc = compress_blocks(v_cmp, blk_idx, cmp_pos_emb, w_cv1, w_cv2)
    n_slc = S // SLC_BLOCK
    top_n = min(SLC_TOPN, n_slc)
    slc_ids = jnp.arange(n_slc)
    slc_start = slc_ids * SLC_BLOCK
    overlap = ((cmp_start[:, None] <= slc_start[None, :] + SLC_BLOCK - 1) & (cmp_end[:, None] >= slc_start[None, :])).astype(q.dtype)
    ks = k_slc.reshape(B, n_slc, SLC_BLOCK, KV, DH).transpose(0, 3, 1, 2, 4)
    vs = v_slc.reshape(B, n_slc, SLC_BLOCK, KV, DH).transpose(0, 3, 1, 2, 4)
    gather_blocks = jax.vmap(jax.vmap(lambda tab, ix: tab[ix]))
    bias_lookup = jax.vmap(lambda tb, d: tb[:, d], in_axes=(0, 1))
    kw = jnp.pad(k_win, ((0, 0), (WINDOW, 0), (0, 0), (0, 0)))
    vw = jnp.pad(v_win, ((0, 0), (WINDOW, 0), (0, 0), (0, 0)))

    def chunk(i):
        s0 = i * Q_CHUNK
        t = s0 + jnp.arange(Q_CHUNK)
        qc = lax.dynamic_slice_in_dim(q, s0, Q_CHUNK, axis=1)
        valid_c = cmp_end[None, :] <= t[:, None]
        bias_c = dist_bias[:, :, jnp.clip(t[:, None] - cmp_end[None, :], 0, S - 1)]
        p_c = masked_softmax(jnp.einsum('bqhgd,bhnd->bhgqn', qc, kc) + bias_c, valid_c).astype(q.dtype)
        o_c = jnp.einsum('bhgqn,bhnd->bqhgd', p_c, vc)
        imp = jnp.einsum('bhgqn,nj->bhqj', p_c, overlap).astype(jnp.float32)
        cur = t[:, None] // SLC_BLOCK
        forced = (slc_ids[None, :] == 0) | (slc_ids[None, :] == cur) | (slc_ids[None, :] == cur - 1)
        future = slc_start[None, :] > t[:, None]
        score = jnp.where(future, NEG_INF, imp + jnp.where(forced, FORCED_BONUS, 0.0))
        _, sel = lax.top_k(score, top_n)
        k_sel = gather_blocks(ks, sel)
        v_sel = gather_blocks(vs, sel)
        pos = sel[..., None] * SLC_BLOCK + jnp.arange(SLC_BLOCK)
        valid_s = (pos <= t[:, None, None]).reshape(B, KV, 1, Q_CHUNK, top_n * SLC_BLOCK)
        bias_s = bias_lookup(dist_bias, jnp.clip(t[:, None, None] - pos, 0, S - 1)).transpose(2, 0, 1, 3, 4, 5)
        logit_s = (jnp.einsum('bqhgd,bhqnkd->bhgqnk', qc, k_sel) + bias_s).reshape(B, KV, G, Q_CHUNK, top_n * SLC_BLOCK)
        p_s = masked_softmax(logit_s, valid_s).astype(q.dtype).reshape(B, KV, G, Q_CHUNK, top_n, SLC_BLOCK)
        o_s = jnp.einsum('bhgqnk,bhqnkd->bqhgd', p_s, v_sel)
        kpos = s0 - WINDOW + jnp.arange(Q_CHUNK + WINDOW)
        k_w = lax.dynamic_slice_in_dim(kw, s0, Q_CHUNK + WINDOW, axis=1)
        v_w = lax.dynamic_slice_in_dim(vw, s0, Q_CHUNK + WINDOW, axis=1)
        rel = t[:, None] - kpos[None, :]
        valid_w = (kpos[None, :] >= 0) & (rel >= 0) & (rel < WINDOW)
        bias_w = dist_bias[:, :, jnp.clip(rel, 0, S - 1)]
        p_w = masked_softmax(jnp.einsum('bqhgd,bkhd->bhgqk', qc, k_w) + bias_w, valid_w).astype(q.dtype)
        o_w = jnp.einsum('bhgqk,bkhd->bqhgd', p_w, v_w)
        return o_c, o_s, o_w

    o_c, o_s, o_w = lax.map(chunk, jnp.arange(S // Q_CHUNK))

    def unchunk(o):
        return jnp.moveaxis(o, 0, 1).reshape(B, S, KV, G, DH)

    gates = jax.nn.sigmoid(gate_logits.reshape(B, S, KV, G, 3))
    o = gates[..., 0:1] * unchunk(o_c) + gates[..., 1:2] * unchunk(o_s) + gates[..., 2:3] * unchunk(o_w)
    return o.reshape(B, S, NSA_Q_W)


def chunk_gated_delta_rule(q, k, v, g, beta):
    B, S, H, DK = q.shape
    DV = v.shape[-1]
    C = DN_CHUNK
    n = S // C
    f32 = jnp.float32

    def chunks(t):
        t = t.astype(f32).reshape((B, n, C, H) + t.shape[3:])
        return jnp.moveaxis(t, 3, 1)

    q, k, v, g, beta = (chunks(t) for t in (q, k, v, g, beta))
    gc = jnp.cumsum(g, axis=-1)
    idx = jnp.arange(C)
    tril = idx[:, None] >= idx[None, :]
    strict = idx[:, None] > idx[None, :]
    diff = gc[..., :, None] - gc[..., None, :]
    decay = jnp.where(tril, jnp.exp(jnp.where(tril, diff, 0.0)), 0.0)
    kb = k * beta[..., None]
    vb = v * beta[..., None]
    a_mat = jnp.where(strict, jnp.einsum('bhnid,bhnjd->bhnij', kb, k) * decay, 0.0) + jnp.eye(C, dtype=f32)
    rhs = jnp.concatenate([vb, kb * jnp.exp(gc)[..., None]], axis=-1)
    sol = lax.linalg.triangular_solve(a_mat, rhs, left_side=True, lower=True, unit_diagonal=True)
    u, w = sol[..., :DV], sol[..., DV:]
    attn = jnp.einsum('bhnid,bhnjd->bhnij', q, k) * decay
    q_dec = q * jnp.exp(gc)[..., None]
    k_dec = k * jnp.exp(gc[..., -1:] - gc)[..., None]
    g_last = jnp.exp(gc[..., -1])

    def step(state, inp):
        q_i, k_i, u_i, w_i, a_i, gl_i = inp
        v_new = u_i - jnp.einsum('bhck,bhkv->bhcv', w_i, state)
        o_i = jnp.einsum('bhck,bhkv->bhcv', q_i, state) + jnp.einsum('bhij,bhjv->bhiv', a_i, v_new)
        state = state * gl_i[..., None, None] + jnp.einsum('bhck,bhcv->bhkv', k_i, v_new)
        return state, o_i

    xs = tuple(jnp.moveaxis(t, 2, 0) for t in (q_dec, k_dec, u, w, attn, g_last))
    _, o = lax.scan(step, jnp.zeros((B, H, DK, DV), f32), xs)
    return jnp.transpose(o, (1, 0, 3, 2, 4)).reshape(B, S, H, DV)


def gated_deltanet(q, k, v, z, b_logits, a_logits, conv_w, A_log, dt_bias, norm_g):
    B, S, _ = q.shape
    f32 = jnp.float32
    qkv = jax.nn.silu(causal_depthwise_conv(jnp.concatenate([q, k, v], axis=-1), conv_w))
    q, k, v = jnp.split(qkv, [DN_QK_W, 2 * DN_QK_W], axis=-1)
    q = l2_normalize(q.reshape(B, S, DN_HEADS, DN_KDIM)) * (DN_KDIM ** -0.5)
    k = l2_normalize(k.reshape(B, S, DN_HEADS, DN_KDIM))
    v = v.reshape(B, S, DN_HEADS, DN_VDIM)
    beta = jax.nn.sigmoid(b_logits.astype(f32))
    g = -jnp.exp(A_log.astype(f32)) * jax.nn.softplus(a_logits.astype(f32) + dt_bias.astype(f32))
    o = chunk_gated_delta_rule(q, k, v, g, beta).astype(z.dtype)
    o = rms_norm(o, norm_g) * jax.nn.silu(z.reshape(B, S, DN_HEADS, DN_VDIM))
    return o.reshape(B, S, DN_V_W)


def token_mixer(h, rel_bias, w_in, cmp_pos_emb, w_ck1, w_ck2, w_cv1, w_cv2, conv_w, A_log, dt_bias, dn_norm_g, w_branch_nsa, w_branch_dn, w_out):
    (nsa_q, k_c, v_c, k_s, v_s, k_w, v_w, nsa_gates, dn_q, dn_k, dn_v, dn_z, dn_b, dn_a, gate_nsa, gate_dn) = jnp.split(h @ w_in, list(IN_SPLIT_POINTS), axis=-1)
    o_nsa = nsa_attention(nsa_q, k_c, v_c, k_s, v_s, k_w, v_w, nsa_gates, rel_bias, cmp_pos_emb, w_ck1, w_ck2, w_cv1, w_cv2)
    o_dn = gated_deltanet(dn_q, dn_k, dn_v, dn_z, dn_b, dn_a, conv_w, A_log, dt_bias, dn_norm_g)
    merged = jax.nn.sigmoid(gate_nsa) * (o_nsa @ w_branch_nsa) + jax.nn.sigmoid(gate_dn) * (o_dn @ w_branch_dn)
    return merged @ w_out


def peer_ffn(h, w_query, keys1, keys2, expert_u, expert_v):
    B, S, D = h.shape
    qry = (h @ w_query).reshape(B, S, PEER_HEADS, PEER_DKEY)
    s1 = jnp.einsum('bshd,hkd->bshk', qry[..., :PEER_HALF], keys1).astype(jnp.float32)
    s2 = jnp.einsum('bshd,hkd->bshk', qry[..., PEER_HALF:], keys2).astype(jnp.float32)
    v1, i1 = lax.top_k(s1, PEER_TOPK)
    v2, i2 = lax.top_k(s2, PEER_TOPK)
    n_cand = PEER_TOPK * PEER_TOPK
    cand_s = (v1[..., :, None] + v2[..., None, :]).reshape(B, S, PEER_HEADS, n_cand)
    cand_i = (i1[..., :, None] * PEER_NKEYS + i2[..., None, :]).reshape(B, S, PEER_HEADS, n_cand)
    top_s, top_pos = lax.top_k(cand_s, PEER_TOPK)
    expert_idx = jnp.take_along_axis(cand_i, top_pos, axis=-1)
    gate = jax.nn.softmax(top_s, axis=-1).astype(h.dtype)
    n_chunks = (B * S) // PEER_TOK_CHUNK
    E = PEER_HEADS * PEER_TOPK
    xs = (h.reshape(n_chunks, PEER_TOK_CHUNK, D), expert_idx.reshape(n_chunks, PEER_TOK_CHUNK, E), gate.reshape(n_chunks, PEER_TOK_CHUNK, E))

    def chunk(args):
        xc, ic, gc = args
        act = jax.nn.gelu(jnp.einsum('td,ted->te', xc, expert_u[ic]))
        return jnp.einsum('te,ted->td', gc * act, expert_v[ic])

    return lax.map(chunk, xs).reshape(B, S, D)


def setup_inputs(seed: int = 0) -> dict:
    key = jax.random.key(seed)
    ks = jax.random.split(key, 32)
    L = DEPTH
    f32 = jnp.float32

    def nrm(k, shape, scale):
        return jax.random.normal(k, shape, f32) * scale

    dt = jnp.exp(jax.random.uniform(ks[16], (L, DN_HEADS), f32, math.log(DT_MIN), math.log(DT_MAX)))
    return {
        'x': nrm(ks[0], (BATCH, SEQ, D_MODEL), 1.0),
        'c': nrm(ks[1], (BATCH, D_MODEL), 1.0),
        'rel_bias': nrm(ks[2], (REL_BUCKETS, NSA_HEADS), 0.2),
        'final_g': 1.0 + nrm(ks[3], (D_MODEL,), 0.02),
        'w_ada': nrm(ks[4], (L, D_MODEL, 6 * D_MODEL), 0.5 * D_MODEL ** -0.5),
        'b_ada': nrm(ks[5], (L, 6 * D_MODEL), 0.02),
        'norm1_g': 1.0 + nrm(ks[6], (L, D_MODEL), 0.02),
        'w_in': nrm(ks[7], (L, D_MODEL, IN_COLS), D_MODEL ** -0.5),
        'cmp_pos_emb': nrm(ks[8], (L, CMP_LEN, HEAD_DIM), 0.1),
        'w_cmp_k1': nrm(ks[9], (L, CMP_LEN * HEAD_DIM, CMP_HIDDEN), (CMP_LEN * HEAD_DIM) ** -0.5),
        'w_cmp_k2': nrm(ks[10], (L, CMP_HIDDEN, HEAD_DIM), CMP_HIDDEN ** -0.5),
        'w_cmp_v1': nrm(ks[11], (L, CMP_LEN * HEAD_DIM, CMP_HIDDEN), (CMP_LEN * HEAD_DIM) ** -0.5),
        'w_cmp_v2': nrm(ks[12], (L, CMP_HIDDEN, HEAD_DIM), CMP_HIDDEN ** -0.5),
        'dn_conv_w': nrm(ks[13], (L, DN_CONV, DN_CONV_W), DN_CONV ** -0.5),
        'dn_A_log': jnp.log(jax.random.uniform(ks[15], (L, DN_HEADS), f32, 1.0, 16.0)),
        'dn_dt_bias': dt + jnp.log(-jnp.expm1(-dt)),
        'dn_norm_g': 1.0 + nrm(ks[17], (L, DN_VDIM), 0.02),
        'w_branch_nsa': nrm(ks[18], (L, NSA_Q_W, D_MODEL), NSA_Q_W ** -0.5),
        'w_branch_dn': nrm(ks[19], (L, DN_V_W, D_MODEL), DN_V_W ** -0.5),
        'w_out': nrm(ks[20], (L, D_MODEL, D_MODEL), D_MODEL ** -0.5),
        'norm2_g': 1.0 + nrm(ks[21], (L, D_MODEL), 0.02),
        'peer_w_query': nrm(ks[22], (L, D_MODEL, PEER_HEADS * PEER_DKEY), D_MODEL ** -0.5),
        'peer_keys1': nrm(ks[23], (L, PEER_HEADS, PEER_NKEYS, PEER_HALF), PEER_HALF ** -0.5),
        'peer_keys2': nrm(ks[24], (L, PEER_HEADS, PEER_NKEYS, PEER_HALF), PEER_HALF ** -0.5),
        'peer_u': nrm(ks[25], (L, PEER_EXPERTS, D_MODEL), D_MODEL ** -0.5),
        'peer_v': nrm(ks[26], (L, PEER_EXPERTS, D_MODEL), 1.0),
    }


def reference(x, c, rel_bias, final_g, w_ada, b_ada, norm1_g, w_in, cmp_pos_emb, w_cmp_k1, w_cmp_k2, w_cmp_v1, w_cmp_v2, dn_conv_w, dn_A_log, dn_dt_bias, dn_norm_g, w_branch_nsa, w_branch_dn, w_out, norm2_g, peer_w_query, peer_keys1, peer_keys2, peer_u, peer_v):
    cond = jax.nn.silu(c)
    for l in range(DEPTH):
        mod = cond @ w_ada[l] + b_ada[l]
        sh1, sc1, g1, sh2, sc2, g2 = (m[:, None, :] for m in jnp.split(mod, 6, axis=-1))
        h = rms_norm(x, norm1_g[l]) * (1.0 + sc1) + sh1
        x = x + g1 * token_mixer(h, rel_bias, w_in[l], cmp_pos_emb[l], w_cmp_k1[l], w_cmp_k2[l], w_cmp_v1[l], w_cmp_v2[l], dn_conv_w[l], dn_A_log[l], dn_dt_bias[l], dn_norm_g[l], w_branch_nsa[l], w_branch_dn[l], w_out[l])
        h = rms_norm(x, norm2_g[l]) * (1.0 + sc2) + sh2
        x = x + g2 * peer_ffn(h, peer_w_query[l], peer_keys1[l], peer_keys2[l], peer_u[l], peer_v[l])
    return rms_norm(x, final_g)
```

```cpp
#include <hip/hip_runtime.h>
#include <cstdio>
#include <cstdint>
namespace pg8 {
#define PG8_LAS __attribute__((address_space(3)))
typedef unsigned short bf16_t;
typedef short bf16x8 __attribute__((ext_vector_type(8)));
typedef float f32x4 __attribute__((ext_vector_type(4)));
typedef unsigned u32x4 __attribute__((ext_vector_type(4)));
constexpr int BM = 256, BK = 64, HALF = 128, HTB = HALF * BK * 2  , STAGE_BYTES = 8 * HTB, NXCD = 8, WGM = 8;

__host__ __device__ __forceinline__ int lds_byte(int r, int c) { const int st = (r >> 4) * 2 + (c >> 5), rr = r & 15, cc = c & 31, ob = rr * 64 + cc * 2; return st * 1024 + (ob ^ (((ob >> 9) & 1) << 5)); }
__host__ __device__ __forceinline__ void stage_rc(int b, int& R, int& C) { const int st = b / 1024, sb = b % 1024, swz = sb ^ (((sb >> 9) & 1) << 5); R = (st >> 1) * 16 + swz / 64; C = (st & 1) * 32 + (swz % 64) / 2; }
__host__ __device__ __forceinline__ int perm32(int rho) { const int n = rho >> 4, i = rho & 15; return 8 * (i >> 2) + 4 * n + (i & 3); }

struct Unit { int pm, pn; };
struct Gemm { const bf16_t* A; const bf16_t* Bt; int M, N, K; };

struct StaticOrder {
    int nM, nN, nwg, G, c;
    __host__ __device__ void init(int M, int N, int G_, int c_) { nM = M / BM; nN = N / BM; nwg = nM * nN; G = G_; c = c_; }
    __host__ __device__ bool next(int i, Unit& u) const {
        const long L = (long)i * G + c; if (L >= nwg) return false;
        int wgid = (int)L; { const int q = nwg / NXCD, r = nwg % NXCD, xcd = wgid % NXCD, off = wgid / NXCD; wgid = (xcd < r ? xcd * (q + 1) : r * (q + 1) + (xcd - r) * q) + off; }
        const int nig = WGM * nN, gid = wgid / nig, fm = gid * WGM, gsz = (nM - fm) < WGM ? (nM - fm) : WGM;
        u.pm = fm + ((wgid % nig) % gsz); u.pn = (wgid % nig) / gsz; return true;
    }
    __device__ __forceinline__ void a_ready(const Unit&) const {}
    __device__ __forceinline__ void done(const Unit&) const {}
};
__device__ __forceinline__ unsigned cvt_pk_bf16(float lo, float hi) { unsigned r; asm volatile("v_cvt_pk_bf16_f32 %0, %1, %2" : "=v"(r) : "v"(lo), "v"(hi)); return r; }
typedef float f32x2 __attribute__((ext_vector_type(2)));
struct EpiStore16 {
    static constexpr bool PERM = true, AFTER_DRAIN = false;
    bf16_t* O; int ldc;
    __device__ __forceinline__ void operator()(const f32x4 (&acc)[2][2][4][2], const Unit& u, int wr, int wc, int fr, int fq) const {
        const int row0 = u.pm * BM + wr * 64 + fr, col0 = u.pn * BM + wc * 32 + 8 * fq;
#pragma unroll
        for (int ai = 0; ai < 2; ++ai)
#pragma unroll
            for (int m = 0; m < 4; ++m) { bf16_t* rowp = O + (size_t)(row0 + ai * HALF + m * 16) * ldc + col0;
#pragma unroll
                for (int bj = 0; bj < 2; ++bj) { const f32x4 v0 = acc[ai][bj][m][0], v1 = acc[ai][bj][m][1];
                    u32x4 w; w.x = cvt_pk_bf16(v0[0], v0[1]); w.y = cvt_pk_bf16(v0[2], v0[3]); w.z = cvt_pk_bf16(v1[0], v1[1]); w.w = cvt_pk_bf16(v1[2], v1[3]);
                    *(u32x4*)(rowp + bj * HALF) = w; } }
    }
};
__device__ __forceinline__ float bfu_lo(unsigned w) { return __uint_as_float(w << 16); }
__device__ __forceinline__ float bfu_hi(unsigned w) { return __uint_as_float(w & 0xffff0000u); }
__device__ __forceinline__ float sigm(float x) { return 1.0f / (1.0f + __expf(-x)); }
template <bool ACCUM> struct EpiGate {
    static constexpr bool PERM = true, AFTER_DRAIN = false;
    bf16_t* O; int ldc; const bf16_t* G; int ldg;
    __device__ __forceinline__ void operator()(const f32x4 (&acc)[2][2][4][2], const Unit& u, int wr, int wc, int fr, int fq) const {
        const int row0 = u.pm * BM + wr * 64 + fr, col0 = u.pn * BM + wc * 32 + 8 * fq;
#pragma unroll
        for (int ai = 0; ai < 2; ++ai)
#pragma unroll
            for (int m = 0; m < 4; ++m) { const size_t row = (size_t)(row0 + ai * HALF + m * 16);
#pragma unroll
                for (int bj = 0; bj < 2; ++bj) { const f32x4 v0 = acc[ai][bj][m][0], v1 = acc[ai][bj][m][1];
                    const u32x4 gw = *(const u32x4*)(G + row * ldg + col0 + bj * HALF);
                    float r[8];
                    r[0] = sigm(bfu_lo(gw.x)) * v0[0]; r[1] = sigm(bfu_hi(gw.x)) * v0[1]; r[2] = sigm(bfu_lo(gw.y)) * v0[2]; r[3] = sigm(bfu_hi(gw.y)) * v0[3];
                    r[4] = sigm(bfu_lo(gw.z)) * v1[0]; r[5] = sigm(bfu_hi(gw.z)) * v1[1]; r[6] = sigm(bfu_lo(gw.w)) * v1[2]; r[7] = sigm(bfu_hi(gw.w)) * v1[3];
                    bf16_t* op = O + row * ldc + col0 + bj * HALF;
                    if (ACCUM) { const u32x4 ow = *(const u32x4*)op;
                        r[0] += bfu_lo(ow.x); r[1] += bfu_hi(ow.x); r[2] += bfu_lo(ow.y); r[3] += bfu_hi(ow.y); r[4] += bfu_lo(ow.z); r[5] += bfu_hi(ow.z); r[6] += bfu_lo(ow.w); r[7] += bfu_hi(ow.w); }
                    u32x4 w; w.x = cvt_pk_bf16(r[0], r[1]); w.y = cvt_pk_bf16(r[2], r[3]); w.z = cvt_pk_bf16(r[4], r[5]); w.w = cvt_pk_bf16(r[6], r[7]);
                    *(u32x4*)op = w; } }
    }
};
struct EpiResid {
    static constexpr bool PERM = false, AFTER_DRAIN = false;
    const float* X; float* O; const float* mod; int goff;
    __device__ __forceinline__ void operator()(const f32x4 (&acc)[2][2][4][2], const Unit& u, int wr, int wc, int fr, int fq) const {
        const int row0 = u.pm * BM + wr * 64 + fr, col0 = u.pn * BM + wc * 32 + 4 * fq;
#pragma unroll
        for (int ai = 0; ai < 2; ++ai)
#pragma unroll
            for (int m = 0; m < 4; ++m) { const int row = row0 + ai * HALF + m * 16; const float* gp = mod + (size_t)(row >> 12) * 6144 + goff;
#pragma unroll
                for (int bj = 0; bj < 2; ++bj)
#pragma unroll
                    for (int n = 0; n < 2; ++n) { const int col = col0 + bj * HALF + n * 16;
                        const f32x4 g = *(const f32x4*)(gp + col); const f32x4 x = *(const f32x4*)(X + (size_t)row * 1024 + col);
                        *(f32x4*)(O + (size_t)row * 1024 + col) = x + g * acc[ai][bj][m][n]; } }
    }
};
template <class Epi, class Sched, bool STAMP = false>
__device__ __forceinline__ void gemm_phase(PG8_LAS unsigned char* lds, const Gemm g, const Sched& S, const Epi& E, unsigned long long* stamps) {
    const int tid = threadIdx.x, wid = __builtin_amdgcn_readfirstlane(tid >> 6), lane = tid & 63, wr = wid >> 2, wc = wid & 3, fr = lane & 15, fq = lane >> 4;
    const int K = g.K, nt = K / BK;
    int ts_lo = 0, ts_hi = 0, nts = 0; const unsigned long long rt_entry = STAMP ? (unsigned long long)wall_clock64() : 0ull;
#define PG8_STAMP() do { if (STAMP && wid == 0 && nts < 64) { const unsigned long long _c = (unsigned long long)clock64(); \
        ts_lo = (lane == nts) ? (int)(unsigned)_c : ts_lo; ts_hi = (lane == nts) ? (int)(unsigned)(_c >> 32) : ts_hi; ++nts; } } while (0)
    PG8_STAMP();
    unsigned voffA[2], voffB[2];
#pragma unroll
    for (int i = 0; i < 2; ++i) { int R, C; stage_rc(tid * 16 + i * 8192, R, C); const int Rb = Epi::PERM ? ((R & ~31) + perm32(R & 31)) : R;
        voffA[i] = (unsigned)(R * K + C) * 2u; voffB[i] = (unsigned)(Rb * K + C) * 2u; }
    const size_t kstep = (size_t)(BK * 2);
    const size_t hstep = (size_t)HALF * K * 2;
    const size_t tstep = 2 * hstep;
    const unsigned ldsw = (unsigned)wid * 1024u;
    const int aoff = lds_byte(wr * 64 + fr, fq * 8), boff = lds_byte(wc * 32 + fr, fq * 8);
#define PG8_SA(b, h) (((b) * 2 + (h)) * HTB)
#define PG8_SB(b, h) ((4 + (b) * 2 + (h)) * HTB)
#define PG8_STAGE(bufoff, gbase, voff) do { _Pragma("unroll") for (int _i = 0; _i < 2; ++_i) \
        __builtin_amdgcn_global_load_lds((const unsigned*)((const char*)(gbase) + (voff)[_i]), (PG8_LAS unsigned*)(lds + (bufoff) + ldsw + _i * 8192), 16, 0, 0); } while (0)
#define PG8_LDA(dst, b, h) do { _Pragma("unroll") for (int m = 0; m < 4; ++m) _Pragma("unroll") for (int k = 0; k < 2; ++k) dst[m][k] = *(const PG8_LAS bf16x8*)(lds + PG8_SA(b, h) + aoff + m * 2048 + k * 1024); } while (0)
#define PG8_LDB(dst, b, h) do { _Pragma("unroll") for (int n = 0; n < 2; ++n) _Pragma("unroll") for (int k = 0; k < 2; ++k) dst[n][k] = *(const PG8_LAS bf16x8*)(lds + PG8_SB(b, h) + boff + n * 2048 + k * 1024); } while (0)
#define PG8_MMA(ai, bj, At, Bt) do { __builtin_amdgcn_s_setprio(1); _Pragma("unroll") for (int m = 0; m < 4; ++m) _Pragma("unroll") for (int n = 0; n < 2; ++n) _Pragma("unroll") for (int k = 0; k < 2; ++k) \
        acc[ai][bj][m][n] = __builtin_amdgcn_mfma_f32_16x16x32_bf16(Bt[n][k], At[m][k], acc[ai][bj][m][n], 0, 0, 0); __builtin_amdgcn_s_setprio(0); } while (0)
#define PG8_WAIT_V(n) asm volatile("s_waitcnt vmcnt(" #n ")" ::: "memory")
#define PG8_WAIT_L(n) asm volatile("s_waitcnt lgkmcnt(" #n ")" ::: "memory")
#define PG8_BAR __builtin_amdgcn_s_barrier()
#define PG8_SCHED __builtin_amdgcn_sched_barrier(0)
    Unit cur, nxt; int ui = 0;
    if (!S.next(0, cur)) return;
    f32x4 acc[2][2][4][2];
#pragma unroll
    for (int a = 0; a < 2; ++a)
#pragma unroll
        for (int b = 0; b < 2; ++b)
#pragma unroll
            for (int m = 0; m < 4; ++m)
#pragma unroll
                for (int n = 0; n < 2; ++n) acc[a][b][m][n] = (f32x4){0.f, 0.f, 0.f, 0.f};
    bf16x8 At[4][2], B0[2][2], B1[2][2];
    const char* cA = (const char*)g.A + (size_t)cur.pm * tstep; const char* cB = (const char*)g.Bt + (size_t)cur.pn * tstep;
    S.a_ready(cur);
    PG8_STAGE(PG8_SB(0, 0), cB, voffB); PG8_STAGE(PG8_SA(0, 0), cA, voffA); PG8_STAGE(PG8_SB(0, 1), cB + hstep, voffB); PG8_STAGE(PG8_SA(0, 1), cA + hstep, voffA);
    if (wr == 1) PG8_BAR;
    PG8_WAIT_V(4); PG8_BAR;
    PG8_STAGE(PG8_SB(1, 0), cB + kstep, voffB); PG8_STAGE(PG8_SA(1, 0), cA + kstep, voffA); PG8_STAGE(PG8_SB(1, 1), cB + hstep + kstep, voffB);
    PG8_WAIT_V(6); PG8_BAR;
    PG8_STAMP();
    for (;;) {
        const bool has_next = S.next(ui + 1, nxt);
        const char* nA = has_next ? (const char*)g.A + (size_t)nxt.pm * tstep : cA; const char* nB = has_next ? (const char*)g.Bt + (size_t)nxt.pn * tstep : cB;
        for (int t = 0; t < nt; t += 2) {
            const bool last = (t == nt - 2);
            const char* a1 = cA + (size_t)(t + 1) * kstep;
            const char* a2 = last ? nA : cA + (size_t)(t + 2) * kstep; const char* b2 = last ? nB : cB + (size_t)(t + 2) * kstep;
            const char* a3 = a2 + kstep; const char* b3 = b2 + kstep;
            if (last && has_next) S.a_ready(nxt);
            PG8_LDB(B0, 0, 0); PG8_SCHED; PG8_LDA(At, 0, 0); PG8_STAGE(PG8_SA(1, 1), a1 + hstep, voffA);
            PG8_WAIT_L(8); PG8_BAR; PG8_WAIT_L(0); PG8_MMA(0, 0, At, B0); PG8_BAR; PG8_SCHED;
            PG8_LDB(B1, 0, 1); PG8_STAGE(PG8_SB(0, 0), b2, voffB);
            PG8_BAR; PG8_WAIT_L(0); PG8_MMA(0, 1, At, B1); PG8_BAR;
            PG8_LDA(At, 0, 1); PG8_STAGE(PG8_SA(0, 0), a2, voffA);
            PG8_BAR; PG8_WAIT_L(0); PG8_MMA(1, 0, At, B0); PG8_BAR; PG8_SCHED;
            PG8_STAGE(PG8_SB(0, 1), b2 + hstep, voffB);
            PG8_WAIT_V(6); PG8_BAR; PG8_MMA(1, 1, At, B1); PG8_BAR;
            PG8_LDB(B0, 1, 0); PG8_SCHED; PG8_LDA(At, 1, 0); PG8_STAGE(PG8_SA(0, 1), a2 + hstep, voffA);
            PG8_WAIT_L(8); PG8_BAR; PG8_WAIT_L(0); PG8_MMA(0, 0, At, B0); PG8_BAR; PG8_SCHED;
            PG8_LDB(B1, 1, 1); PG8_STAGE(PG8_SB(1, 0), b3, voffB);
            PG8_BAR; PG8_WAIT_L(0); PG8_MMA(0, 1, At, B1); PG8_BAR;
            PG8_LDA(At, 1, 1); PG8_STAGE(PG8_SA(1, 0), a3, voffA);
            PG8_BAR; PG8_WAIT_L(0); PG8_MMA(1, 0, At, B0); PG8_BAR; PG8_SCHED;
            PG8_STAGE(PG8_SB(1, 1), b3 + hstep, voffB);
            PG8_WAIT_V(6); PG8_BAR; PG8_MMA(1, 1, At, B1); PG8_BAR;
        }
        PG8_STAMP();
        if constexpr (!Epi::AFTER_DRAIN) { E(acc, cur, wr, wc, fr, fq); S.done(cur); }
        PG8_STAMP();
        if (!has_next) break;
#pragma unroll
        for (int a = 0; a < 2; ++a)
#pragma unroll
            for (int b = 0; b < 2; ++b)
#pragma unroll
                for (int m = 0; m < 4; ++m)
#pragma unroll
                    for (int n = 0; n < 2; ++n) acc[a][b][m][n] = (f32x4){0.f, 0.f, 0.f, 0.f};
        cur = nxt; cA = nA; cB = nB; ++ui;
    }
    PG8_WAIT_V(0);
    if (wr == 0) PG8_BAR;
    PG8_BAR;
    if constexpr (Epi::AFTER_DRAIN) { E.fused(acc, cur, wr, wc, fr, fq, lds, wid, lane); S.done(cur); }
    PG8_STAMP();
    if (STAMP && wid == 0) { stamps[lane] = lane < nts ? (((unsigned long long)(unsigned)ts_hi << 32) | (unsigned)ts_lo) : 0ull;
        if (lane == 62) stamps[62] = rt_entry; if (lane == 63) stamps[63] = (unsigned long long)wall_clock64(); }
#undef PG8_STAMP
#undef PG8_SA
#undef PG8_SB
#undef PG8_STAGE
#undef PG8_LDA
#undef PG8_LDB
#undef PG8_MMA
#undef PG8_WAIT_V
#undef PG8_WAIT_L
#undef PG8_BAR
#undef PG8_SCHED
}
}
#define XB_TMO      128
#define XB_XCNT(j)  (256  + 64 * (j))
#define XB_XSUB(j)  (1280 + 64 * (j))
#define XB_XGEN(j)  (2304 + 64 * (j))
#define XB_TOP      3328
#define XB_TOPGEN   3392
#define XCD_BAR_WORDS 3456
#define XB_SPIN_CAP (1u << 18)
#define LAS __attribute__((address_space(3)))

__device__ __forceinline__ unsigned xb_ld(unsigned* p)              { return __hip_atomic_load(p, __ATOMIC_RELAXED, __HIP_MEMORY_SCOPE_AGENT); }
__device__ __forceinline__ unsigned xb_add(unsigned* p, unsigned v) { return __hip_atomic_fetch_add(p, v, __ATOMIC_RELAXED, __HIP_MEMORY_SCOPE_AGENT); }
__device__ __forceinline__ unsigned xb_xcc_id() { return (unsigned)__builtin_amdgcn_s_getreg((3 << 11) | 20) & 0xFu; }
#define XB_SPIN(cond, bar) do { unsigned _sp = 0; while (cond) { __builtin_amdgcn_s_sleep(1); \
    if ((++_sp & 255u) == 0u) { if (xb_ld(&(bar)[XB_TMO])) break; if (_sp > XB_SPIN_CAP) { atomicAdd(&(bar)[XB_TMO], 1u); break; } } } } while (0)

struct XcdBarrier {
    unsigned* bar; unsigned x;
    volatile LAS unsigned* st;
};

__device__ __forceinline__ XcdBarrier xcd_barrier_post(unsigned* bar, volatile LAS unsigned* st) {
    XcdBarrier b; b.bar = bar; b.x = xb_xcc_id(); b.st = st;
    if (threadIdx.x == 0) (void)xb_add(&bar[XB_XCNT(b.x)], 1u);
    return b;
}
__device__ __forceinline__ void xcd_barrier_complete(unsigned* bar, unsigned x, unsigned& nloc, unsigned& nx) {
    const unsigned G = gridDim.x * gridDim.y * gridDim.z;
    unsigned sum, cnt, mine, sp = 0u;
    for (;;) {
        sum = 0u; cnt = 0u; mine = 0u;
#pragma unroll
        for (unsigned j = 0; j < 16; ++j) { const unsigned c = xb_ld(&bar[XB_XCNT(j)]); sum += c; cnt += (c > 0u) ? 1u : 0u; mine = (j == x) ? c : mine; }
        if (sum == G) break;
        __builtin_amdgcn_s_sleep(1);
        if ((++sp & 255u) == 0u) { if (xb_ld(&bar[XB_TMO])) break; if (sp > XB_SPIN_CAP) { atomicAdd(&bar[XB_TMO], 1u); break; } }
    }
    nloc = mine > 0u ? mine : 1u; nx = cnt > 0u ? cnt : 1u;
}

__device__ __forceinline__ void xcd_barrier(const XcdBarrier& b) {
    asm volatile("s_waitcnt vmcnt(0)" ::: "memory");
    __syncthreads();
    if (threadIdx.x == 0) {
        unsigned* bar = b.bar;
        __builtin_amdgcn_s_waitcnt(0);
        unsigned nloc = b.st[0], nx = b.st[1];
        if (nloc == 0u) { xcd_barrier_complete(bar, b.x, nloc, nx); b.st[0] = nloc; b.st[1] = nx; }
        const unsigned old = xb_add(&bar[XB_XSUB(b.x)], 1u);
        const unsigned gen = old / nloc;
        if (old + 1u == (gen + 1u) * nloc) {
            __builtin_amdgcn_fence(__ATOMIC_RELEASE, "agent");
            asm volatile("s_waitcnt vmcnt(0)" ::: "memory");
            const unsigned og = xb_add(&bar[XB_TOP], 1u);
            const unsigned tg = og / nx;
            if (og + 1u == (tg + 1u) * nx) xb_add(&bar[XB_TOPGEN], 1u);
            else XB_SPIN(xb_ld(&bar[XB_TOPGEN]) == tg, bar);
            __builtin_amdgcn_fence(__ATOMIC_ACQUIRE, "agent");
            xb_add(&bar[XB_XGEN(b.x)], 1u);
            asm volatile("s_waitcnt vmcnt(0)" ::: "memory");
        } else {
            XB_SPIN(xb_ld(&bar[XB_XGEN(b.x)]) == gen, bar);
            __builtin_amdgcn_fence(__ATOMIC_ACQUIRE, "agent");
            asm volatile("s_waitcnt vmcnt(0)" ::: "memory");
        }
    }
    __syncthreads();
}
#define DI __device__ __forceinline__
typedef unsigned short bf16_t;
typedef short bf16x8 __attribute__((ext_vector_type(8)));
typedef float f32x4 __attribute__((ext_vector_type(4)));
typedef float f32x16 __attribute__((ext_vector_type(16)));
typedef unsigned u32x4 __attribute__((ext_vector_type(4)));
typedef unsigned u32x2 __attribute__((ext_vector_type(2)));

constexpr int NTOK = 32768, DM = 1024, SEQ = 4096;
constexpr int NP = 5632;
constexpr int CQ = 0, CKC = 512, CVC = 640, CKS = 768, CVS = 896, CKW = 1024, CVW = 1152, CDQ = 1280, CDK = 1792, CDV = 2304, CZ = 2816, CGN = 3328, CGD = 4352, CNG = 5376, CB = 5400, CA = 5408;
constexpr size_t OFF_CTR = 16384, OFF_MOD = 20480, OFF_C1 = 217088, OFF_BTAB = 217600, OFF_GL = 221696;
constexpr size_t OFF_WIN = 262144, OFF_WN = 11796480, OFF_WD = 12845056, OFF_WO = 13893632, OFF_WQ = 15990784;
constexpr size_t OFF_W1K = 18087936, OFF_W1V = 18350080, OFF_W2K = 18612224, OFF_W2V = 18620416, OFF_KEYS = 18628608;
constexpr size_t OFF_KC = 18890752, OFF_VCT = 19415040, OFF_VTS = 19939328, OFF_VTW = 28327936;
constexpr size_t OFF_P = 37748736;
constexpr size_t OFF_WF = 406847488, OFF_UF = OFF_WF + 33554432, OFF_AF = OFF_UF + 33554432;
constexpr size_t WS_NEED = OFF_AF + 33554432;
constexpr size_t OFF_X1 = OFF_P, OFF_H2 = OFF_P + 134217728, OFF_QRY = OFF_H2 + 67108864, OFF_UBF = OFF_QRY + 67108864, OFF_VBF = OFF_UBF + 33554432;
constexpr size_t OUT_H1 = 0, OUT_QF = 0, OUT_KF = 33554432, OUT_MRG = 0, OUT_ONSA = 67108864, OUT_ODN = 100663296;
constexpr int LDS_BYTES = 147456, LDS_USER = 256;

struct Params { const float* in[26]; float* out; unsigned char* ws; };

DI float bf2f(bf16_t b) { return __uint_as_float(((unsigned)b) << 16); }
DI float blo(unsigned w) { return __uint_as_float(w << 16); }
DI float bhi(unsigned w) { return __uint_as_float(w & 0xffff0000u); }
DI bf16_t f2bf(float f) { unsigned u = __float_as_uint(f); u += 0x7FFFu + ((u >> 16) & 1u); return (bf16_t)(u >> 16); }
DI unsigned pack2(float lo, float hi) { return (unsigned)f2bf(lo) | ((unsigned)f2bf(hi) << 16); }
DI bf16x8 pack8(const f32x16& v, int s) {
    u32x4 p; p.x = pack2(v[8 * s], v[8 * s + 1]); p.y = pack2(v[8 * s + 2], v[8 * s + 3]); p.z = pack2(v[8 * s + 4], v[8 * s + 5]); p.w = pack2(v[8 * s + 6], v[8 * s + 7]);
    return __builtin_bit_cast(bf16x8, p);
}
DI f32x16 zero16() { f32x16 z;
#pragma unroll
    for (int i = 0; i < 16; ++i) z[i] = 0.f; return z; }
#define MFMA32(a, b, c) __builtin_amdgcn_mfma_f32_32x32x16_bf16((a), (b), (c), 0, 0, 0)
DI int crow(int r, int hh) { return 8 * (r >> 2) + 4 * hh + (r & 3); }
DI float wave_sum(float v) { v += __shfl_xor(v, 32); v += __shfl_xor(v, 16); v += __shfl_xor(v, 8); v += __shfl_xor(v, 4); v += __shfl_xor(v, 2); v += __shfl_xor(v, 1); return v; }
DI float siluf(float x) { return x / (1.0f + __expf(-x)); }
DI float sigmf(float x) { return 1.0f / (1.0f + __expf(-x)); }
DI float gelu_tanh(float x) { const float u = 0.7978845608028654f * (x + 0.044715f * x * x * x); return x / (1.0f + __expf(-2.0f * u)); }
DI int vperm16(int j) { return (j & 3) + 4 * (j >> 3) + 8 * ((j >> 2) & 1); }

DI int winmap(int n) {
    if (n < 1280) return n;
    if (n < 3328) return n + 24;
    if (n < 5376) return n + 40;
    if (n < 5400) return n - 5376 + 1280;
    if (n < 5408) return n - 5400 + 3352;
    if (n < 5416) return n - 5408 + 3360;
    return -1;
}
DI void cvt_tile(const float* src, int ld, bf16_t* dst, int K, int kt, int nt, bool usemap, LAS float* T) {
    const int tid = threadIdx.x;
    { const int r = tid >> 4, c4 = (tid & 15) * 4;
#pragma unroll
      for (int ps = 0; ps < 2; ++ps) { const int k = kt * 64 + r + 32 * ps, n = nt * 64 + c4; const int sc = usemap ? winmap(n) : n;
          f32x4 v = (f32x4){0.f, 0.f, 0.f, 0.f}; if (sc >= 0) v = *(const f32x4*)(src + (size_t)k * ld + sc);
          LAS float* tp = T + (r + 32 * ps) * 65 + c4; tp[0] = v[0]; tp[1] = v[1]; tp[2] = v[2]; tp[3] = v[3]; } }
    __syncthreads();
    { const int n = tid >> 3, kc = (tid & 7) * 8; float v[8];
#pragma unroll
      for (int j = 0; j < 8; ++j) v[j] = T[(kc + j) * 65 + n];
      u32x4 w; w.x = pack2(v[0], v[1]); w.y = pack2(v[2], v[3]); w.z = pack2(v[4], v[5]); w.w = pack2(v[6], v[7]);
      *(u32x4*)(dst + (size_t)(nt * 64 + n) * K + kt * 64 + kc) = w; }
    __syncthreads();
}
DI void cvt_flat(const float* src, bf16_t* dst, size_t n, int bid, int nb) {
    for (size_t i = ((size_t)bid * 512 + threadIdx.x) * 8; i < n; i += (size_t)nb * 512 * 8) {
        const f32x4 a = *(const f32x4*)(src + i), b = *(const f32x4*)(src + i + 4);
        u32x4 w; w.x = pack2(a[0], a[1]); w.y = pack2(a[2], a[3]); w.z = pack2(b[0], b[1]); w.w = pack2(b[2], b[3]);
        *(u32x4*)(dst + i) = w; }
}
DI void phase_prologue(const Params& p, LAS unsigned char* L, int bid, int nb) {
    const int tid = threadIdx.x;
    unsigned char* ws = p.ws;
    for (int cb = bid; cb < 192; cb += nb) {
        LAS float* cond = (LAS float*)L; LAS float* red = (LAS float*)(L + 32768);
        for (int i = tid; i < 8192; i += 512) cond[i] = siluf(p.in[1][i]);
        __syncthreads();
        const int cl = tid & 31, ks = tid >> 5, n = cb * 32 + cl;
        const float* w = p.in[4] + (size_t)(ks * 64) * 6144 + n;
        float acc[8];
#pragma unroll
        for (int b = 0; b < 8; ++b) acc[b] = 0.f;
        for (int k = 0; k < 64; ++k) { const float wv = w[(size_t)k * 6144];
#pragma unroll
            for (int b = 0; b < 8; ++b) acc[b] += cond[b * 1024 + ks * 64 + k] * wv; }
#pragma unroll
        for (int b = 0; b < 8; ++b) red[(ks * 8 + b) * 32 + cl] = acc[b];
        __syncthreads();
        if (tid < 256) { const int b = tid >> 5, c2 = tid & 31; float s = p.in[5][cb * 32 + c2];
            for (int k2 = 0; k2 < 16; ++k2) s += red[(k2 * 8 + b) * 32 + c2];
            ((float*)(ws + OFF_MOD))[b * 6144 + cb * 32 + c2] = s; }
        __syncthreads();
    }
    for (int t = bid; t < 2242; t += nb) {
        LAS float* T = (LAS float*)L;
        if (t < 1408) cvt_tile(p.in[7], 5416, (bf16_t*)(ws + OFF_WIN), 1024, t / 88, t % 88, true, T);
        else if (t < 1536) { const int u = t - 1408; cvt_tile(p.in[17], 1024, (bf16_t*)(ws + OFF_WN), 512, u / 16, u % 16, false, T); }
        else if (t < 1664) { const int u = t - 1536; cvt_tile(p.in[18], 1024, (bf16_t*)(ws + OFF_WD), 512, u / 16, u % 16, false, T); }
        else if (t < 1920) { const int u = t - 1664; cvt_tile(p.in[19], 1024, (bf16_t*)(ws + OFF_WO), 1024, u / 16, u % 16, false, T); }
        else if (t < 2176) { const int u = t - 1920; cvt_tile(p.in[21], 1024, (bf16_t*)(ws + OFF_WQ), 1024, u / 16, u % 16, false, T); }
        else if (t < 2208) { const int u = t - 2176; cvt_tile(p.in[9], 64, (bf16_t*)(ws + OFF_W1K), 2048, u, 0, false, T); }
        else if (t < 2240) { const int u = t - 2208; cvt_tile(p.in[11], 64, (bf16_t*)(ws + OFF_W1V), 2048, u, 0, false, T); }
        else if (t == 2240) cvt_tile(p.in[10], 64, (bf16_t*)(ws + OFF_W2K), 64, 0, 0, false, T);
        else cvt_tile(p.in[12], 64, (bf16_t*)(ws + OFF_W2V), 64, 0, 0, false, T);
    }
    cvt_flat(p.in[22], (bf16_t*)(ws + OFF_KEYS), 65536, bid, nb);
    cvt_flat(p.in[23], (bf16_t*)(ws + OFF_KEYS) + 65536, 65536, bid, nb);
    for (int wch = 0; wch < 2; ++wch) if (bid == (200 + wch) % nb) {
        LAS float* red = (LAS float*)L; const float* w1 = p.in[wch ? 11 : 9]; const float* pos = p.in[8];
        const int j = tid & 63, ks = tid >> 6; float s = 0.f;
        for (int e = ks * 256; e < ks * 256 + 256; ++e) s += pos[e] * w1[(size_t)e * 64 + j];
        red[ks * 64 + j] = s; __syncthreads();
        if (tid < 64) { float t2 = 0.f; for (int k2 = 0; k2 < 8; ++k2) t2 += red[k2 * 64 + tid]; ((float*)(ws + OFF_C1))[wch * 64 + tid] = t2; }
        __syncthreads();
    }
    if (bid == 202 % nb) {
        for (int i = tid; i < 1024; i += 512) { const int h = i >> 7, d = i & 127; int bk;
            if (d < 16) bk = d; else { const float sc = logf((float)d / 16.0f) / logf(8.0f); bk = 16 + (int)(sc * 16.0f); if (bk > 31) bk = 31; }
            ((float*)(ws + OFF_BTAB))[i] = p.in[2][bk * 8 + h]; }
    }
}
DI void norm_rows(const float* src, const float* g, const float* mod, int shoff, int scoff, bf16_t* dst, int bid, int nb) {
    const int wave = threadIdx.x >> 6, lane = threadIdx.x & 63;
    for (int tok = bid * 8 + wave; tok < NTOK; tok += nb * 8) {
        const float* xr = src + (size_t)tok * DM; const float* mb = mod + (size_t)(tok >> 12) * 6144;
        f32x4 v[4]; v[0] = *(const f32x4*)(xr + lane * 8); v[1] = *(const f32x4*)(xr + lane * 8 + 4); v[2] = *(const f32x4*)(xr + 512 + lane * 8); v[3] = *(const f32x4*)(xr + 512 + lane * 8 + 4);
        float ss = 0.f;
#pragma unroll
        for (int q = 0; q < 4; ++q) ss += v[q][0] * v[q][0] + v[q][1] * v[q][1] + v[q][2] * v[q][2] + v[q][3] * v[q][3];
        ss = wave_sum(ss); const float rstd = rsqrtf(ss * (1.0f / 1024.0f) + 1e-6f);
        float y[16];
#pragma unroll
        for (int q = 0; q < 4; ++q) { const int c = (q >> 1) * 512 + lane * 8 + (q & 1) * 4;
            const f32x4 gg = *(const f32x4*)(g + c), sc = *(const f32x4*)(mb + scoff + c), sh = *(const f32x4*)(mb + shoff + c);
#pragma unroll
            for (int j = 0; j < 4; ++j) y[q * 4 + j] = v[q][j] * rstd * gg[j] * (1.0f + sc[j]) + sh[j]; }
        u32x4 w0, w1; w0.x = pack2(y[0], y[1]); w0.y = pack2(y[2], y[3]); w0.z = pack2(y[4], y[5]); w0.w = pack2(y[6], y[7]);
        w1.x = pack2(y[8], y[9]); w1.y = pack2(y[10], y[11]); w1.z = pack2(y[12], y[13]); w1.w = pack2(y[14], y[15]);
        *(u32x4*)(dst + (size_t)tok * DM + lane * 8) = w0; *(u32x4*)(dst + (size_t)tok * DM + 512 + lane * 8) = w1;
    }
}
constexpr int DNU_LDS = 35840;
DI void dn_prep(const Params& p, LAS unsigned char* L, int bid, int nb) {
    const int tid = threadIdx.x, sub = tid >> 7, tau = tid & 127, lane = tid & 63, wu = tau >> 6, l31 = lane & 31, hh = lane >> 5;
    unsigned char* ws = p.ws;
    const bf16_t* P = (const bf16_t*)(ws + OFF_P);
    bf16_t* QF = (bf16_t*)((unsigned char*)p.out + OUT_QF); bf16_t* KF = (bf16_t*)((unsigned char*)p.out + OUT_KF);
    bf16_t* WF = (bf16_t*)(ws + OFF_WF); bf16_t* UF = (bf16_t*)(ws + OFF_UF); bf16_t* AF = (bf16_t*)(ws + OFF_AF); float* GL = (float*)(ws + OFF_GL);
    const float* conv_w = p.in[13];
    LAS unsigned char* UB = L + sub * DNU_LDS;
    LAS bf16_t* qn = (LAS bf16_t*)UB; LAS bf16_t* kn = (LAS bf16_t*)(UB + 9216); LAS float* Am = (LAS float*)(UB + 18432);
    LAS float* sbeta = (LAS float*)(UB + 34816); LAS float* sgc = sbeta + 64; LAS float* sg = sbeta + 128;
    for (int ub = bid; ub < 1024; ub += nb) {
        const int un = ub * 4 + sub, c = un & 63, h = (un >> 6) & 7, b = un >> 9;
        const size_t tok0 = (size_t)b * SEQ + c * 64, uoff = (size_t)un * 4096;
        if (tau < 64) { const size_t tok = tok0 + tau; const float a = bf2f(P[tok * NP + CA + h]), bl = bf2f(P[tok * NP + CB + h]);
            const float x = a + p.in[15][h]; const float sp = x > 20.f ? x : log1pf(__expf(x));
            sg[tau] = -__expf(p.in[14][h]) * sp; sbeta[tau] = sigmf(bl); }
        __syncthreads();
        if (tau < 64) { int tq = tau; asm volatile("" : "+v"(tq));
            float s = 0.f; for (int j = 0; j < 64; ++j) { const float gj = sg[j]; s += (j <= tq) ? gj : 0.f; } sgc[tau] = s; }
        __syncthreads();
        { const int t = tau >> 1, hf = tau & 1, spos = c * 64 + t; const float gct = sgc[t]; const float eq = __expf(gct), ek = __expf(sgc[63] - gct);
#pragma unroll 1
          for (int part = 0; part < 2; ++part) {
            const int col0 = (part ? CDK : CDQ) + h * 64 + hf * 32, ch0 = part * 512 + h * 64 + hf * 32;
            float y[32];
#pragma unroll
            for (int v = 0; v < 4; ++v) { float a8[8];
#pragma unroll
                for (int j = 0; j < 8; ++j) a8[j] = 0.f;
#pragma unroll
                for (int i = 0; i < 4; ++i) { if (spos - 3 + i >= 0) {
                    const u32x4 raw = *(const u32x4*)(P + (tok0 + t + i - 3) * NP + col0 + v * 8);
                    const float* cw = conv_w + i * 1536 + ch0 + v * 8; const f32x4 w0 = *(const f32x4*)cw, w1 = *(const f32x4*)(cw + 4);
                    a8[0] += w0[0] * blo(raw.x); a8[1] += w0[1] * bhi(raw.x); a8[2] += w0[2] * blo(raw.y); a8[3] += w0[3] * bhi(raw.y);
                    a8[4] += w1[0] * blo(raw.z); a8[5] += w1[1] * bhi(raw.z); a8[6] += w1[2] * blo(raw.w); a8[7] += w1[3] * bhi(raw.w); } }
#pragma unroll
                for (int j = 0; j < 8; ++j) y[v * 8 + j] = siluf(a8[j]); }
            float ss = 0.f;
#pragma unroll
            for (int d = 0; d < 32; ++d) ss += y[d] * y[d];
            ss += __shfl_xor(ss, 1);
            const float rn = rsqrtf(ss + 1e-6f) * (part == 0 ? 0.125f : 1.0f);
#pragma unroll
            for (int d = 0; d < 32; ++d) y[d] *= rn;
            LAS bf16_t* tile = part ? kn : qn;
#pragma unroll
            for (int v = 0; v < 4; ++v) { u32x4 w; w.x = pack2(y[v * 8], y[v * 8 + 1]); w.y = pack2(y[v * 8 + 2], y[v * 8 + 3]); w.z = pack2(y[v * 8 + 4], y[v * 8 + 5]); w.w = pack2(y[v * 8 + 6], y[v * 8 + 7]);
                *(LAS u32x4*)(tile + t * 72 + hf * 32 + v * 8) = w; }
            if (part == 0) {
#pragma unroll
                for (int s2 = 0; s2 < 2; ++s2)
#pragma unroll
                    for (int hp = 0; hp < 2; ++hp) { const int o = 16 * s2 + 4 * hp; u32x4 w;
                        w.x = pack2(y[o] * eq, y[o + 1] * eq); w.y = pack2(y[o + 2] * eq, y[o + 3] * eq); w.z = pack2(y[o + 8] * eq, y[o + 9] * eq); w.w = pack2(y[o + 10] * eq, y[o + 11] * eq);
                        *(u32x4*)(QF + uoff + (size_t)((((t >> 5) * 4 + 2 * hf + s2) * 64 + (t & 31) + 32 * hp) * 8)) = w; }
            } else {
                const int s = t >> 4, j16 = t & 15, hp = (j16 >> 2) & 1, e = (j16 & 3) + 4 * (j16 >> 3);
#pragma unroll
                for (int d = 0; d < 32; ++d) KF[uoff + (size_t)(((hf * 4 + s) * 64 + d + 32 * hp) * 8 + e)] = f2bf(y[d] * ek);
            }
          } }
        __syncthreads();
        { bf16x8 kf[2][4], qf[4];
#pragma unroll
          for (int rt = 0; rt < 2; ++rt)
#pragma unroll
            for (int s = 0; s < 4; ++s) kf[rt][s] = *(const LAS bf16x8*)(kn + (32 * rt + l31) * 72 + 16 * s + 8 * hh);
#pragma unroll
          for (int s = 0; s < 4; ++s) qf[s] = *(const LAS bf16x8*)(qn + (32 * wu + l31) * 72 + 16 * s + 8 * hh);
          f32x16 dk[2], da[2]; dk[0] = zero16(); dk[1] = zero16(); da[0] = zero16(); da[1] = zero16();
#pragma unroll
          for (int s = 0; s < 4; ++s) { const bf16x8 kb = wu ? kf[1][s] : kf[0][s];
              dk[0] = MFMA32(kf[0][s], kb, dk[0]); dk[1] = MFMA32(kf[1][s], kb, dk[1]);
              da[0] = MFMA32(kf[0][s], qf[s], da[0]); da[1] = MFMA32(kf[1][s], qf[s], da[1]); }
          int jc = 32 * wu + l31; asm volatile("" : "+v"(jc)); const float gcj = sgc[jc];
#pragma unroll
          for (int it = 0; it < 2; ++it)
#pragma unroll
            for (int r = 0; r < 16; ++r) { const int i = 32 * it + crow(r, hh); float v = 0.f;
                if (i > jc) v = sbeta[i] * dk[it][r] * __expf(sgc[i] - gcj);
                Am[i * 64 + jc] = v; }
#pragma unroll
          for (int jt = 0; jt < 2; ++jt)
#pragma unroll
            for (int s2 = 0; s2 < 2; ++s2) { float e8[8];
#pragma unroll
                for (int e = 0; e < 8; ++e) { const int r = 8 * s2 + e, j = 32 * jt + crow(r, hh); e8[e] = (jc >= j) ? da[jt][r] * __expf(gcj - sgc[j]) : 0.f; }
                u32x4 w; w.x = pack2(e8[0], e8[1]); w.y = pack2(e8[2], e8[3]); w.z = pack2(e8[4], e8[5]); w.w = pack2(e8[6], e8[7]);
                *(u32x4*)(AF + uoff + (size_t)(((wu * 4 + 2 * jt + s2) * 64 + lane) * 8)) = w; }
        }
        __syncthreads();
        { float x[64];
          if (tau < 64) { const int colv = CDV + h * 64 + tau; const float* cw = conv_w + 1024 + h * 64 + tau;
              const float w0 = cw[0], w1 = cw[1536], w2 = cw[3072], w3 = cw[4608];
              float x0 = 0.f, x1 = 0.f, x2 = 0.f;
              if (c > 0) { x0 = bf2f(P[(tok0 - 3) * NP + colv]); x1 = bf2f(P[(tok0 - 2) * NP + colv]); x2 = bf2f(P[(tok0 - 1) * NP + colv]); }
              const bf16_t* pv = P + tok0 * NP + colv;
#pragma unroll
              for (int i = 0; i < 64; ++i) { const float x3 = bf2f(*pv); pv += NP; asm volatile("" : "+v"(pv));
                  const float yv = w0 * x0 + w1 * x1 + w2 * x2 + w3 * x3;
                  x[i] = siluf(yv) * sbeta[i]; x0 = x1; x1 = x2; x2 = x3; }
          } else { const int kk = tau - 64;
#pragma unroll
              for (int i = 0; i < 64; ++i) x[i] = bf2f(kn[i * 72 + kk]) * sbeta[i] * __expf(sgc[i]); }
#pragma unroll
          for (int i = 1; i < 64; ++i) { float s = x[i];
#pragma unroll
              for (int j4 = 0; j4 < (i + 3) / 4; ++j4) { const f32x4 a = *(const LAS f32x4*)(Am + i * 64 + 4 * j4);
                  s -= a[0] * x[4 * j4]; s -= a[1] * x[4 * j4 + 1]; s -= a[2] * x[4 * j4 + 2]; s -= a[3] * x[4 * j4 + 3]; }
              x[i] = s; }
          if (tau < 64) { const int slice = tau >> 5;
#pragma unroll
              for (int rt = 0; rt < 2; ++rt)
#pragma unroll
                for (int hp = 0; hp < 2; ++hp) { u32x4 wa, wb; const int o = 32 * rt + 4 * hp;
                    wa.x = pack2(x[o], x[o + 1]); wa.y = pack2(x[o + 2], x[o + 3]); wa.z = pack2(x[o + 8], x[o + 9]); wa.w = pack2(x[o + 10], x[o + 11]);
                    wb.x = pack2(x[o + 16], x[o + 17]); wb.y = pack2(x[o + 18], x[o + 19]); wb.z = pack2(x[o + 24], x[o + 25]); wb.w = pack2(x[o + 26], x[o + 27]);
                    bf16_t* dp = UF + uoff + (size_t)((((slice * 2 + rt) * 64) + (tau & 31) + 32 * hp) * 16);
                    *(u32x4*)dp = wa; *(u32x4*)(dp + 8) = wb; }
          } else { const int kk = tau - 64;
#pragma unroll
              for (int i = 0; i < 64; ++i) qn[i * 72 + kk] = f2bf(x[i]); }
        }
        __syncthreads();
#pragma unroll
        for (int q = 0; q < 4; ++q) { const int pid = tau + 128 * q, rt = pid >> 8, s = (pid >> 6) & 3, lp = pid & 63, row = 32 * rt + (lp & 31), hp = lp >> 5;
            const u32x2 lo = *(const LAS u32x2*)(qn + row * 72 + 16 * s + 4 * hp), hi = *(const LAS u32x2*)(qn + row * 72 + 16 * s + 8 + 4 * hp);
            u32x4 w; w.x = lo.x; w.y = lo.y; w.z = hi.x; w.w = hi.y;
            *(u32x4*)(WF + uoff + (size_t)pid * 8) = w; }
        if (tau == 0) GL[un] = __expf(sgc[63]);
        __syncthreads();
    }
}
DI void dn_scan(const Params& p, LAS unsigned char* L, int bh) {
    const int tid = threadIdx.x, wave = tid >> 6, lane = tid & 63, l31 = lane & 31, hh = lane >> 5, b = bh >> 3, h = bh & 7;
    unsigned char* ws = p.ws;
    const bf16_t* P = (const bf16_t*)(ws + OFF_P);
    const bf16_t* src[5] = { (const bf16_t*)(ws + OFF_WF), (const bf16_t*)((unsigned char*)p.out + OUT_KF), (const bf16_t*)((unsigned char*)p.out + OUT_QF), (const bf16_t*)(ws + OFF_AF), (const bf16_t*)(ws + OFF_UF) };
    const float* GL = (const float*)(ws + OFF_GL);
    bf16_t* ODN = (bf16_t*)((unsigned char*)p.out + OUT_ODN);
    LAS float* ot = (LAS float*)(L + 81920);
    u32x4 pre[5];
    { const size_t un = (size_t)bh * 64;
#pragma unroll
      for (int k = 0; k < 5; ++k) pre[k] = *(const u32x4*)(src[k] + un * 4096 + tid * 8);
#pragma unroll
      for (int k = 0; k < 5; ++k) *(LAS u32x4*)(L + k * 8192 + tid * 16) = pre[k]; }
    __syncthreads();
    f32x16 S[2]; S[0] = zero16(); S[1] = zero16();
    for (int c = 0; c < 64; ++c) {
        const size_t un = (size_t)bh * 64 + c;
        if (c < 63) {
#pragma unroll
            for (int k = 0; k < 5; ++k) pre[k] = *(const u32x4*)(src[k] + (un + 1) * 4096 + tid * 8); }
        if (wave < 2) {
            const int sl = wave;
            LAS unsigned char* B = L + (c & 1) * 40960;
            LAS unsigned char* Wt = B; LAS unsigned char* Kt = B + 8192; LAS unsigned char* Qt = B + 16384; LAS unsigned char* At = B + 24576; LAS unsigned char* Ut = B + 32768;
            bf16x8 Sb[4]; Sb[0] = pack8(S[0], 0); Sb[1] = pack8(S[0], 1); Sb[2] = pack8(S[1], 0); Sb[3] = pack8(S[1], 1);
            f32x16 T1[2]; T1[0] = zero16(); T1[1] = zero16();
#pragma unroll
            for (int rt = 0; rt < 2; ++rt)
#pragma unroll
                for (int sp = 0; sp < 4; ++sp) T1[rt] = MFMA32(*(const LAS bf16x8*)(Wt + ((rt * 4 + sp) * 64 + lane) * 16), Sb[sp], T1[rt]);
            f32x16 vn[2];
#pragma unroll
            for (int rt = 0; rt < 2; ++rt) { const u32x4 ua = *(const LAS u32x4*)(Ut + ((sl * 2 + rt) * 64 + lane) * 32), ub = *(const LAS u32x4*)(Ut + ((sl * 2 + rt) * 64 + lane) * 32 + 16);
                vn[rt][0] = blo(ua.x) - T1[rt][0]; vn[rt][1] = bhi(ua.x) - T1[rt][1]; vn[rt][2] = blo(ua.y) - T1[rt][2]; vn[rt][3] = bhi(ua.y) - T1[rt][3];
                vn[rt][4] = blo(ua.z) - T1[rt][4]; vn[rt][5] = bhi(ua.z) - T1[rt][5]; vn[rt][6] = blo(ua.w) - T1[rt][6]; vn[rt][7] = bhi(ua.w) - T1[rt][7];
                vn[rt][8] = blo(ub.x) - T1[rt][8]; vn[rt][9] = bhi(ub.x) - T1[rt][9]; vn[rt][10] = blo(ub.y) - T1[rt][10]; vn[rt][11] = bhi(ub.y) - T1[rt][11];
                vn[rt][12] = blo(ub.z) - T1[rt][12]; vn[rt][13] = bhi(ub.z) - T1[rt][13]; vn[rt][14] = blo(ub.w) - T1[rt][14]; vn[rt][15] = bhi(ub.w) - T1[rt][15]; }
            bf16x8 Vb[4]; Vb[0] = pack8(vn[0], 0); Vb[1] = pack8(vn[0], 1); Vb[2] = pack8(vn[1], 0); Vb[3] = pack8(vn[1], 1);
            f32x16 O[2]; O[0] = zero16(); O[1] = zero16();
#pragma unroll
            for (int rt = 0; rt < 2; ++rt)
#pragma unroll
                for (int sp = 0; sp < 4; ++sp) { O[rt] = MFMA32(*(const LAS bf16x8*)(Qt + ((rt * 4 + sp) * 64 + lane) * 16), Sb[sp], O[rt]);
                                                 O[rt] = MFMA32(*(const LAS bf16x8*)(At + ((rt * 4 + sp) * 64 + lane) * 16), Vb[sp], O[rt]); }
            const float gl = GL[un];
#pragma unroll
            for (int rt = 0; rt < 2; ++rt) {
#pragma unroll
                for (int r = 0; r < 16; ++r) S[rt][r] *= gl;
#pragma unroll
                for (int sp = 0; sp < 4; ++sp) S[rt] = MFMA32(*(const LAS bf16x8*)(Kt + ((rt * 4 + sp) * 64 + lane) * 16), Vb[sp], S[rt]); }
#pragma unroll
            for (int rt = 0; rt < 2; ++rt)
#pragma unroll
                for (int r = 0; r < 16; ++r) ot[(32 * rt + crow(r, hh)) * 65 + 32 * sl + l31] = O[rt][r];
        }
        if (c < 63) {
#pragma unroll
            for (int k = 0; k < 5; ++k) *(LAS u32x4*)(L + ((c + 1) & 1) * 40960 + k * 8192 + tid * 16) = pre[k]; }
        __syncthreads();
        { const int t = tid >> 3, part = tid & 7; float o8[8]; float ss = 0.f;
#pragma unroll
          for (int j = 0; j < 8; ++j) { o8[j] = ot[t * 65 + part * 8 + j]; ss += o8[j] * o8[j]; }
          ss += __shfl_xor(ss, 1); ss += __shfl_xor(ss, 2); ss += __shfl_xor(ss, 4);
          const float rstd = rsqrtf(ss * (1.0f / 64.0f) + 1e-6f);
          const size_t tok = (size_t)b * SEQ + c * 64 + t;
          const u32x4 zr = *(const u32x4*)(P + tok * NP + CZ + h * 64 + part * 8);
          const float* ng = p.in[16] + part * 8;
          float z8[8]; z8[0] = blo(zr.x); z8[1] = bhi(zr.x); z8[2] = blo(zr.y); z8[3] = bhi(zr.y); z8[4] = blo(zr.z); z8[5] = bhi(zr.z); z8[6] = blo(zr.w); z8[7] = bhi(zr.w);
          float y8[8];
#pragma unroll
          for (int j = 0; j < 8; ++j) y8[j] = o8[j] * rstd * ng[j] * siluf(z8[j]);
          u32x4 w; w.x = pack2(y8[0], y8[1]); w.y = pack2(y8[2], y8[3]); w.z = pack2(y8[4], y8[5]); w.w = pack2(y8[6], y8[7]);
          *(u32x4*)(ODN + tok * 512 + h * 64 + part * 8) = w; }
        __syncthreads();
    }
}
DI void compress_task(const Params& p, LAS unsigned char* L, int task) {
    const int tid = threadIdx.x, w = tid >> 6, lane = tid & 63, l31 = lane & 31, hh = lane >> 5;
    unsigned char* ws = p.ws;
    const int which = task >> 7, rem = task & 127, b = rem >> 4, kvh = (rem >> 3) & 1, nt = rem & 7;
    const bf16_t* P = (const bf16_t*)(ws + OFF_P);
    const bf16_t* W1T = (const bf16_t*)(ws + (which ? OFF_W1V : OFF_W1K)); const bf16_t* W2T = (const bf16_t*)(ws + (which ? OFF_W2V : OFF_W2K));
    const int col = (which ? CVC : CKC) + kvh * 64, n = nt * 32 + l31, nc = n < 254 ? n : 254;
    f32x16 acc[2]; acc[0] = zero16(); acc[1] = zero16();
#pragma unroll 2
    for (int ksl = 0; ksl < 16; ++ksl) { const int ks = 16 * w + ksl, ltok = ks >> 2, d0 = (ks & 3) * 16 + 8 * hh;
        const bf16x8 bfr = *(const bf16x8*)(P + ((size_t)b * SEQ + 16 * nc + ltok) * NP + col + d0);
#pragma unroll
        for (int rt = 0; rt < 2; ++rt) { const bf16x8 a = *(const bf16x8*)(W1T + (size_t)(32 * rt + l31) * 2048 + 16 * ks + 8 * hh); acc[rt] = MFMA32(a, bfr, acc[rt]); } }
    LAS float* red = (LAS float*)L;
#pragma unroll
    for (int rt = 0; rt < 2; ++rt)
#pragma unroll
        for (int r = 0; r < 16; ++r) red[((w * 2 + rt) * 16 + r) * 64 + lane] = acc[rt][r];
    __syncthreads();
    if (w == 0) {
        const float* c1 = (const float*)(ws + OFF_C1) + which * 64;
        f32x16 G[2];
#pragma unroll
        for (int rt = 0; rt < 2; ++rt)
#pragma unroll
            for (int r = 0; r < 16; ++r) { float s = c1[32 * rt + crow(r, hh)];
#pragma unroll
                for (int w2 = 0; w2 < 8; ++w2) s += red[((w2 * 2 + rt) * 16 + r) * 64 + lane];
                G[rt][r] = gelu_tanh(s); }
        bf16x8 Hb[4]; Hb[0] = pack8(G[0], 0); Hb[1] = pack8(G[0], 1); Hb[2] = pack8(G[1], 0); Hb[3] = pack8(G[1], 1);
        bf16_t* KC = (bf16_t*)(ws + OFF_KC); bf16_t* VCT = (bf16_t*)(ws + OFF_VCT);
#pragma unroll
        for (int ot = 0; ot < 2; ++ot) { f32x16 o = zero16(); const int row = 32 * ot + l31;
#pragma unroll
            for (int sp = 0; sp < 4; ++sp) { const u32x2 lo = *(const u32x2*)(W2T + row * 64 + 16 * sp + 4 * hh), hi = *(const u32x2*)(W2T + row * 64 + 16 * sp + 8 + 4 * hh);
                u32x4 aw; aw.x = lo.x; aw.y = lo.y; aw.z = hi.x; aw.w = hi.y; o = MFMA32(__builtin_bit_cast(bf16x8, aw), Hb[sp], o); }
            if (which == 0) {
#pragma unroll
                for (int a = 0; a < 4; ++a) { u32x2 wv; wv.x = pack2(o[4 * a], o[4 * a + 1]); wv.y = pack2(o[4 * a + 2], o[4 * a + 3]);
                    *(u32x2*)(KC + ((size_t)((b * 2 + kvh) * 256 + n)) * 64 + 32 * ot + 8 * a + 4 * hh) = wv; }
            } else {
#pragma unroll
                for (int r = 0; r < 16; ++r) VCT[((size_t)((b * 2 + kvh) * 64 + 32 * ot + crow(r, hh))) * 256 + (n & ~15) + vperm16(n & 15)] = f2bf(o[r]);
            }
        }
    }
    __syncthreads();
}
DI void vtrans_unit(const Params& p, LAS unsigned char* L, int unit) {
    const int tid = threadIdx.x;
    unsigned char* ws = p.ws;
    const int which = unit >> 10, rem = unit & 1023, b = rem >> 7, kvh = (rem >> 6) & 1, blk = rem & 63;
    const bf16_t* P = (const bf16_t*)(ws + OFF_P);
    bf16_t* VT = (bf16_t*)(ws + (which ? OFF_VTW : OFF_VTS));
    LAS bf16_t* tile = (LAS bf16_t*)L;
    { const int tok = tid >> 3, ch = tid & 7;
      const u32x4 v = *(const u32x4*)(P + ((size_t)b * SEQ + blk * 64 + tok) * NP + (which ? CVW : CVS) + kvh * 64 + ch * 8);
      *(LAS u32x4*)(tile + tok * 72 + ch * 8) = v; }
    __syncthreads();
    { const int d = tid >> 3, ch = tid & 7, grp = ch >> 1, hq = ch & 1; bf16_t e8[8];
#pragma unroll
      for (int e = 0; e < 8; ++e) e8[e] = tile[(16 * grp + 8 * (e >> 2) + 4 * hq + (e & 3)) * 72 + d];
      u32x4 w; w.x = (unsigned)e8[0] | ((unsigned)e8[1] << 16); w.y = (unsigned)e8[2] | ((unsigned)e8[3] << 16); w.z = (unsigned)e8[4] | ((unsigned)e8[5] << 16); w.w = (unsigned)e8[6] | ((unsigned)e8[7] << 16);
      *(u32x4*)(VT + ((size_t)((b * 2 + kvh) * 64 + d)) * SEQ + blk * 64 + ch * 8) = w; }
    __syncthreads();
}
constexpr int AT_K = 0, AT_V = 18432, AT_IMP = 36864, AT_BT = 53504, AT_SEL = 55552, AT_TL = 56064, AT_OACC = 57344;
struct AttnCtx { int i, g, th, l31, hh, lane, tid, tq; };
template <int BR, int MODE>
DI void attn_tiles(LAS unsigned char* L, const AttnCtx& cx, const bf16_t* Kbase, size_t kpitch, const bf16_t* VTbase, size_t vpitch, int ntiles, int id0,
                   const bf16x8 (&Qf)[4], float& m, float& l, f32x16 (&O)[2]) {
    if (ntiles <= 0) return;
    const int tid = cx.tid, l31 = cx.l31, hh = cx.hh;
    LAS int* tl = (LAS int*)(L + AT_TL); LAS float* bt = (LAS float*)(L + AT_BT) + cx.g * 128; LAS float* imp = (LAS float*)(L + AT_IMP); LAS unsigned* selm = (LAS unsigned*)(L + AT_SEL);
    const int srow = tid >> 3, sch = tid & 7;
    u32x4 kreg, vreg;
    { const int id = (BR == 1) ? tl[1] : id0;
      kreg = *(const u32x4*)(Kbase + (size_t)(id * 64 + srow) * kpitch + sch * 8);
      if (MODE == 0) vreg = *(const u32x4*)(VTbase + (size_t)srow * vpitch + id * 64 + sch * 8);
      *(LAS u32x4*)(L + AT_K + srow * 144 + sch * 16) = kreg;
      if (MODE == 0) *(LAS u32x4*)(L + AT_V + srow * 144 + sch * 16) = vreg; }
    __syncthreads();
    const float inv = (MODE == 1) ? (l > 0.f ? 1.0f / l : 0.f) : 0.f;
    for (int k = 0; k < ntiles; ++k) {
        const int id = (BR == 1) ? tl[1 + k] : id0 + k;
        if (k + 1 < ntiles) { const int idn = (BR == 1) ? tl[2 + k] : id0 + k + 1;
            kreg = *(const u32x4*)(Kbase + (size_t)(idn * 64 + srow) * kpitch + sch * 8);
            if (MODE == 0) vreg = *(const u32x4*)(VTbase + (size_t)srow * vpitch + idn * 64 + sch * 8); }
        LAS unsigned char* Kt = L + AT_K + (k & 1) * 9216; LAS unsigned char* Vt = L + AT_V + (k & 1) * 9216;
        const int lastpos = (BR == 0) ? (16 * (id * 64 + 63) + 31) : (id * 64 + 63);
        const bool cbias = (64 * cx.i - lastpos) >= 127;
        const float bconst = bt[127];
        unsigned selbit = 1u;
        if (BR == 1) selbit = (selm[(32 * cx.th + l31) * 2 + (id >> 5)] >> (id & 31)) & 1u;
#pragma unroll 1
        for (int kt = 0; kt < 2; ++kt) {
            f32x16 Sx = zero16();
#pragma unroll
            for (int s = 0; s < 4; ++s) Sx = MFMA32(*(const LAS bf16x8*)(Kt + (32 * kt + l31) * 144 + (16 * s + 8 * hh) * 2), Qf[s], Sx);
            const int kbase = id * 64 + 32 * kt + 4 * hh;
            float sc[16]; bool vd[16];
#pragma unroll
            for (int r = 0; r < 16; ++r) { const int kidx = kbase + 8 * (r >> 2) + (r & 3);
                const int dist = (BR == 0) ? (cx.tq - (16 * kidx + 31)) : (cx.tq - kidx);
                bool v = dist >= 0; if (BR == 2) v = v && (dist < 512); if (BR == 1) v = v && (selbit != 0u);
                float bias = bconst; if (!cbias) { int dd = dist < 0 ? 0 : dist; dd = dd > 127 ? 127 : dd; bias = bt[dd]; }
                sc[r] = Sx[r] * 0.125f + bias; vd[r] = v; }
            if (MODE == 0) {
                float mx = -1e30f;
#pragma unroll
                for (int r = 0; r < 16; ++r) mx = fmaxf(mx, vd[r] ? sc[r] : -1e30f);
                mx = fmaxf(mx, __shfl_xor(mx, 32));
                const float mn = fmaxf(m, mx), alpha = __expf(m - mn);
                f32x16 pr; float rs = 0.f;
#pragma unroll
                for (int r = 0; r < 16; ++r) { pr[r] = vd[r] ? __expf(sc[r] - mn) : 0.f; rs += pr[r]; }
                rs += __shfl_xor(rs, 32);
                l = l * alpha + rs; m = mn;
#pragma unroll
                for (int r = 0; r < 16; ++r) { O[0][r] *= alpha; O[1][r] *= alpha; }
                const bf16x8 Pb0 = pack8(pr, 0), Pb1 = pack8(pr, 1);
#pragma unroll
                for (int dt = 0; dt < 2; ++dt) {
                    O[dt] = MFMA32(*(const LAS bf16x8*)(Vt + (32 * dt + l31) * 144 + (32 * kt + 8 * hh) * 2), Pb0, O[dt]);
                    O[dt] = MFMA32(*(const LAS bf16x8*)(Vt + (32 * dt + l31) * 144 + (32 * kt + 16 + 8 * hh) * 2), Pb1, O[dt]); }
            } else {
#pragma unroll
                for (int a = 0; a < 4; ++a) { float s4 = 0.f, p3 = 0.f;
#pragma unroll
                    for (int b2 = 0; b2 < 4; ++b2) { const int r = 4 * a + b2; const float pv = vd[r] ? __expf(sc[r] - m) * inv : 0.f; s4 += pv; if (b2 == 3) p3 = pv; }
                    const int jblk = 16 * id + 8 * kt + 2 * a + hh;
                    LAS float* ip = imp + (32 * cx.th + l31) * 65 + jblk;
                    __hip_atomic_fetch_add(ip, s4, __ATOMIC_RELAXED, __HIP_MEMORY_SCOPE_WORKGROUP);
                    if (jblk + 1 < 64) __hip_atomic_fetch_add(ip + 1, p3, __ATOMIC_RELAXED, __HIP_MEMORY_SCOPE_WORKGROUP); }
            }
        }
        if (k + 1 < ntiles) { *(LAS u32x4*)(L + AT_K + ((k + 1) & 1) * 9216 + srow * 144 + sch * 16) = kreg;
            if (MODE == 0) *(LAS u32x4*)(L + AT_V + ((k + 1) & 1) * 9216 + srow * 144 + sch * 16) = vreg; }
        __syncthreads();
    }
}
DI void attn_unit(const Params& p, LAS unsigned char* L, int unit) {
    AttnCtx cx; cx.tid = threadIdx.x; const int wave = cx.tid >> 6; cx.lane = cx.tid & 63; cx.l31 = cx.lane & 31; cx.hh = cx.lane >> 5; cx.g = wave >> 1; cx.th = wave & 1;
    unsigned char* ws = p.ws;
    const int i = 63 - (unit >> 4), bk = unit & 15, b = bk >> 1, kvh = bk & 1, hq = kvh * 4 + cx.g;
    cx.i = i; cx.tq = 64 * i + 32 * cx.th + cx.l31;
    const bf16_t* P = (const bf16_t*)(ws + OFF_P);
    const size_t tokq = (size_t)b * SEQ + cx.tq;
    LAS float* imp = (LAS float*)(L + AT_IMP); LAS unsigned* selm = (LAS unsigned*)(L + AT_SEL); LAS int* tl = (LAS int*)(L + AT_TL);
    bf16x8 Qf[4];
#pragma unroll
    for (int s = 0; s < 4; ++s) Qf[s] = *(const bf16x8*)(P + tokq * NP + CQ + hq * 64 + 16 * s + 8 * cx.hh);
    const float g0 = sigmf(bf2f(P[tokq * NP + CNG + hq * 3 + 0])), g1 = sigmf(bf2f(P[tokq * NP + CNG + hq * 3 + 1])), g2 = sigmf(bf2f(P[tokq * NP + CNG + hq * 3 + 2]));
    ((LAS float*)(L + AT_BT))[cx.tid] = ((const float*)(ws + OFF_BTAB))[kvh * 512 + cx.tid];
    for (int q = cx.tid; q < 64 * 65; q += 512) imp[q] = 0.f;
    if (cx.tid < 128) selm[cx.tid] = 0u;
    __syncthreads();
    LAS float* oab = (LAS float*)(L + AT_OACC) + (wave * 32) * 64 + cx.lane;
    { const bf16_t* KC = (const bf16_t*)(ws + OFF_KC) + (size_t)((b * 2 + kvh) * 256) * 64; const bf16_t* VCT = (const bf16_t*)(ws + OFF_VCT) + (size_t)((b * 2 + kvh) * 64) * 256;
      const int nt = ((4 * i + 2) >> 6) + 1;
      float m = -1e30f, l = 0.f; f32x16 O[2]; O[0] = zero16(); O[1] = zero16();
      attn_tiles<0, 0>(L, cx, KC, 64, VCT, 256, nt, 0, Qf, m, l, O);
      const float sc0 = l > 0.f ? g0 / l : 0.f;
#pragma unroll
      for (int r = 0; r < 16; ++r) { oab[r * 64] = O[0][r] * sc0; oab[(16 + r) * 64] = O[1][r] * sc0; }
      attn_tiles<0, 1>(L, cx, KC, 64, VCT, 256, nt, 0, Qf, m, l, O);
    }
    __syncthreads();
    { const int q = cx.tid & 63, w8 = cx.tid >> 6; float myv[8]; int cnt[8];
#pragma unroll
      for (int jj = 0; jj < 8; ++jj) { const int j = 8 * w8 + jj; myv[jj] = imp[q * 65 + j] + ((j == 0 || j == i || j == i - 1) ? 1.0e4f : 0.f); cnt[jj] = 0; }
      for (int j2 = 0; j2 <= i; ++j2) { const float v = imp[q * 65 + j2] + ((j2 == 0 || j2 == i || j2 == i - 1) ? 1.0e4f : 0.f);
#pragma unroll
          for (int jj = 0; jj < 8; ++jj) { const int j = 8 * w8 + jj; cnt[jj] += ((v > myv[jj]) || (v == myv[jj] && j2 < j)) ? 1 : 0; } }
      unsigned bits = 0u;
#pragma unroll
      for (int jj = 0; jj < 8; ++jj) { const int j = 8 * w8 + jj; if (j <= i && cnt[jj] < 16) bits |= 1u << jj; }
      __hip_atomic_fetch_or(selm + q * 2 + (w8 >> 2), bits << ((w8 & 3) * 8), __ATOMIC_RELAXED, __HIP_MEMORY_SCOPE_WORKGROUP);
    }
    __syncthreads();
    if (wave == 0) { unsigned u0 = selm[cx.lane * 2], u1 = selm[cx.lane * 2 + 1];
#pragma unroll
        for (int o = 32; o >= 1; o >>= 1) { u0 |= __shfl_xor(u0, o); u1 |= __shfl_xor(u1, o); }
        if (cx.lane == 0) { int n = 0; for (int j = 0; j <= i; ++j) { const unsigned bit = (j < 32 ? (u0 >> j) : (u1 >> (j - 32))) & 1u; if (bit) { tl[1 + n] = j; ++n; } } tl[0] = n; } }
    __syncthreads();
    { const bf16_t* KS = P + ((size_t)b * SEQ) * NP + CKS + kvh * 64; const bf16_t* VTS = (const bf16_t*)(ws + OFF_VTS) + (size_t)((b * 2 + kvh) * 64) * SEQ;
      const int nt = tl[0];
      float m = -1e30f, l = 0.f; f32x16 O[2]; O[0] = zero16(); O[1] = zero16();
      attn_tiles<1, 0>(L, cx, KS, NP, VTS, SEQ, nt, 0, Qf, m, l, O);
      const float sc1 = l > 0.f ? g1 / l : 0.f;
#pragma unroll
      for (int r = 0; r < 16; ++r) { oab[r * 64] += O[0][r] * sc1; oab[(16 + r) * 64] += O[1][r] * sc1; }
    }
    { const bf16_t* KW = P + ((size_t)b * SEQ) * NP + CKW + kvh * 64; const bf16_t* VTW = (const bf16_t*)(ws + OFF_VTW) + (size_t)((b * 2 + kvh) * 64) * SEQ;
      const int j0 = i > 8 ? i - 8 : 0;
      float m = -1e30f, l = 0.f; f32x16 O[2]; O[0] = zero16(); O[1] = zero16();
      attn_tiles<2, 0>(L, cx, KW, NP, VTW, SEQ, i - j0 + 1, j0, Qf, m, l, O);
      const float sc2 = l > 0.f ? g2 / l : 0.f;
      bf16_t* ONSA = (bf16_t*)((unsigned char*)p.out + OUT_ONSA);
#pragma unroll
      for (int dt = 0; dt < 2; ++dt)
#pragma unroll
        for (int a = 0; a < 4; ++a) { float o4[4];
#pragma unroll
            for (int j = 0; j < 4; ++j) o4[j] = oab[(16 * dt + 4 * a + j) * 64] + O[dt][4 * a + j] * sc2;
            u32x2 wv; wv.x = pack2(o4[0], o4[1]); wv.y = pack2(o4[2], o4[3]);
            *(u32x2*)(ONSA + tokq * 512 + hq * 64 + 32 * dt + 8 * a + 4 * cx.hh) = wv; }
    }
    __syncthreads();
}
DI unsigned f2ord(float f) { const unsigned b = __float_as_uint(f); return (b & 0x80000000u) ? ~b : (b | 0x80000000u); }
DI float ord2f(unsigned u) { return __uint_as_float((u & 0x80000000u) ? (u & 0x7FFFFFFFu) : ~u); }
DI unsigned umax(unsigned a, unsigned b) { return a > b ? a : b; }
DI unsigned umin(unsigned a, unsigned b) { return a < b ? a : b; }
DI void ins16(unsigned (&t)[16], unsigned x) {
#pragma unroll
    for (int i = 0; i < 16; ++i) { const unsigned hi = umax(t[i], x); x = umin(t[i], x); t[i] = hi; } }
DI unsigned sel16(const unsigned (&v)[16], int i) { unsigned r = v[0];
#pragma unroll
    for (int j = 1; j < 16; ++j) { r = (i == j) ? v[j] : r; asm volatile("" : "+v"(r)); } return r; }
DI void route_half(const bf16_t* QRY, const bf16_t* KEYS, size_t tok, int hd, int half, int l31, int hh, unsigned (&top)[16]) {
    bf16x8 qf[4];
#pragma unroll
    for (int s = 0; s < 4; ++s) qf[s] = *(const bf16x8*)(QRY + tok * 1024 + hd * 128 + half * 64 + 16 * s + 8 * hh);
#pragma unroll
    for (int k = 0; k < 16; ++k) top[k] = 0u;
#pragma unroll 1
    for (int kt = 0; kt < 4; ++kt) { f32x16 D = zero16();
#pragma unroll
        for (int s = 0; s < 4; ++s) { const bf16x8 a = *(const bf16x8*)(KEYS + (size_t)(((half * 8 + hd) * 128) + 32 * kt + l31) * 64 + 16 * s + 8 * hh); D = MFMA32(a, qf[s], D); }
#pragma unroll
        for (int r = 0; r < 16; ++r) { const int key = 32 * kt + crow(r, hh); const unsigned u = (f2ord(D[r]) & ~0x7Fu) | (unsigned)(127 - key); ins16(top, u); } }
    unsigned cc[16];
#pragma unroll
    for (int k = 0; k < 16; ++k) cc[k] = (unsigned)__shfl_xor((int)top[k], 32);
#pragma unroll
    for (int k = 0; k < 16; ++k) top[k] = umax(top[k], cc[15 - k]);
#define BSTAGE(d) _Pragma("unroll") for (int k = 0; k < 16; ++k) if ((k & (d)) == 0) { const unsigned hi = umax(top[k], top[k + (d)]), lo = umin(top[k], top[k + (d)]); top[k] = hi; top[k + (d)] = lo; }
    BSTAGE(8) BSTAGE(4) BSTAGE(2) BSTAGE(1)
#undef BSTAGE
}
constexpr int PE_IDX = 0, PE_GATE = 32768;
DI void peer_phase(const Params& p, LAS unsigned char* L, int bid, int nb) {
    const int tid = threadIdx.x, wave = tid >> 6, lane = tid & 63, l31 = lane & 31, hh = lane >> 5;
    unsigned char* ws = p.ws;
    const bf16_t* QRY = (const bf16_t*)(ws + OFF_QRY); const bf16_t* KEYS = (const bf16_t*)(ws + OFF_KEYS); const bf16_t* H2 = (const bf16_t*)(ws + OFF_H2);
    const bf16_t* UBF = (const bf16_t*)(ws + OFF_UBF); const bf16_t* VBF = (const bf16_t*)(ws + OFF_VBF);
    const float* X1 = (const float*)(ws + OFF_X1); const float* mod = (const float*)(ws + OFF_MOD);
    LAS unsigned short* lidx = (LAS unsigned short*)(L + PE_IDX); LAS float* lgate = (LAS float*)(L + PE_GATE);
    for (int tb = bid; tb < NTOK / 128; tb += nb) {
#ifndef NO_ROUTER
        for (int task = wave; task < 32; task += 8) {
            const int tt = task >> 3, hd = task & 7; const size_t tok = (size_t)tb * 128 + tt * 32 + l31;
            unsigned v1[16], v2[16];
            route_half(QRY, KEYS, tok, hd, 0, l31, hh, v1);
            route_half(QRY, KEYS, tok, hd, 1, l31, hh, v2);
            unsigned t16[16];
#pragma unroll
            for (int k = 0; k < 16; ++k) t16[k] = 0u;
#pragma unroll
            for (int i1 = 0; i1 < 16; ++i1) { const float a = ord2f(v1[i1]);
#pragma unroll
                for (int i2 = 0; i2 < 16; ++i2) if ((i1 + 1) * (i2 + 1) <= 16) { const float sm = a + ord2f(v2[i2]); ins16(t16, (f2ord(sm) & ~0xFFu) | (unsigned)(255 - (i1 * 16 + i2))); } }
            const float mx = ord2f(t16[0]); float e[16]; float ssum = 0.f;
#pragma unroll
            for (int k = 0; k < 16; ++k) { e[k] = __expf(ord2f(t16[k]) - mx); ssum += e[k]; }
            const float rinv = 1.0f / ssum;
#pragma unroll
            for (int k = 0; k < 16; ++k) { const int ci = 255 - (int)(t16[k] & 0xFFu), i1 = ci >> 4, i2 = ci & 15;
                const int k1 = 127 - (int)(sel16(v1, i1) & 0x7Fu), k2 = 127 - (int)(sel16(v2, i2) & 0x7Fu);
                if (hh == 0) { lidx[(tt * 32 + l31) * 128 + hd * 16 + k] = (unsigned short)(k1 * 128 + k2); lgate[(tt * 32 + l31) * 128 + hd * 16 + k] = e[k] * rinv; } }
        }
#endif
        __syncthreads();
#ifndef NO_EXPERTS
        for (int tl = wave; tl < 128; tl += 8) {
            const size_t tok = (size_t)tb * 128 + tl;
            float hf[16];
            { const u32x4 ha = *(const u32x4*)(H2 + tok * 1024 + lane * 8), hb = *(const u32x4*)(H2 + tok * 1024 + 512 + lane * 8);
              hf[0] = blo(ha.x); hf[1] = bhi(ha.x); hf[2] = blo(ha.y); hf[3] = bhi(ha.y); hf[4] = blo(ha.z); hf[5] = bhi(ha.z); hf[6] = blo(ha.w); hf[7] = bhi(ha.w);
              hf[8] = blo(hb.x); hf[9] = bhi(hb.x); hf[10] = blo(hb.y); hf[11] = bhi(hb.y); hf[12] = blo(hb.z); hf[13] = bhi(hb.z); hf[14] = blo(hb.w); hf[15] = bhi(hb.w); }
            float acc[16];
#pragma unroll
            for (int j = 0; j < 16; ++j) acc[j] = 0.f;
            u32x4 ua[4], ub[4], va[4], vb[4];
#pragma unroll
            for (int q = 0; q < 4; ++q) { const size_t ro = (size_t)__builtin_amdgcn_readfirstlane((int)lidx[tl * 128 + q]) * 1024;
                ua[q] = *(const u32x4*)(UBF + ro + lane * 8); ub[q] = *(const u32x4*)(UBF + ro + 512 + lane * 8); va[q] = *(const u32x4*)(VBF + ro + lane * 8); vb[q] = *(const u32x4*)(VBF + ro + 512 + lane * 8); }
            for (int e0 = 0; e0 < 128; e0 += 4) {
                u32x4 cua[4], cub[4], cva[4], cvb[4];
#pragma unroll
                for (int q = 0; q < 4; ++q) { cua[q] = ua[q]; cub[q] = ub[q]; cva[q] = va[q]; cvb[q] = vb[q]; }
                if (e0 + 4 < 128) {
#pragma unroll
                    for (int q = 0; q < 4; ++q) { const size_t ro = (size_t)__builtin_amdgcn_readfirstlane((int)lidx[tl * 128 + e0 + 4 + q]) * 1024;
                        ua[q] = *(const u32x4*)(UBF + ro + lane * 8); ub[q] = *(const u32x4*)(UBF + ro + 512 + lane * 8); va[q] = *(const u32x4*)(VBF + ro + lane * 8); vb[q] = *(const u32x4*)(VBF + ro + 512 + lane * 8); } }
                float d[4];
#pragma unroll
                for (int q = 0; q < 4; ++q) { const u32x4 a = cua[q], b = cub[q];
                    d[q] = hf[0] * blo(a.x) + hf[1] * bhi(a.x) + hf[2] * blo(a.y) + hf[3] * bhi(a.y) + hf[4] * blo(a.z) + hf[5] * bhi(a.z) + hf[6] * blo(a.w) + hf[7] * bhi(a.w)
                         + hf[8] * blo(b.x) + hf[9] * bhi(b.x) + hf[10] * blo(b.y) + hf[11] * bhi(b.y) + hf[12] * blo(b.z) + hf[13] * bhi(b.z) + hf[14] * blo(b.w) + hf[15] * bhi(b.w); }
                const bool hb1 = hh != 0, b4 = ((lane >> 4) & 1) != 0;
                float k0 = hb1 ? d[2] : d[0], k1 = hb1 ? d[3] : d[1];
                const float s0 = hb1 ? d[0] : d[2], s1 = hb1 ? d[1] : d[3];
                k0 += __shfl_xor(s0, 32); k1 += __shfl_xor(s1, 32);
                float kk = b4 ? k1 : k0; const float sx = b4 ? k0 : k1;
                kk += __shfl_xor(sx, 16);
                kk += __shfl_xor(kk, 8); kk += __shfl_xor(kk, 4); kk += __shfl_xor(kk, 2); kk += __shfl_xor(kk, 1);
#pragma unroll
                for (int q = 0; q < 4; ++q) { const float tot = __uint_as_float(__builtin_amdgcn_readlane(__float_as_uint(kk), 16 * q)); const float coef = lgate[tl * 128 + e0 + q] * gelu_tanh(tot);
                    const u32x4 a = cva[q], b = cvb[q];
                    acc[0] += coef * blo(a.x); acc[1] += coef * bhi(a.x); acc[2] += coef * blo(a.y); acc[3] += coef * bhi(a.y); acc[4] += coef * blo(a.z); acc[5] += coef * bhi(a.z); acc[6] += coef * blo(a.w); acc[7] += coef * bhi(a.w);
                    acc[8] += coef * blo(b.x); acc[9] += coef * bhi(b.x); acc[10] += coef * blo(b.y); acc[11] += coef * bhi(b.y); acc[12] += coef * blo(b.z); acc[13] += coef * bhi(b.z); acc[14] += coef * blo(b.w); acc[15] += coef * bhi(b.w); }
            }
            const float* xr = X1 + tok * 1024; const float* g2 = mod + (size_t)(tok >> 12) * 6144 + 5120; const float* fg = p.in[3];
            float y[16]; float ss = 0.f;
#pragma unroll
            for (int q = 0; q < 4; ++q) { const int c = (q >> 1) * 512 + lane * 8 + (q & 1) * 4; const f32x4 xv = *(const f32x4*)(xr + c), gv = *(const f32x4*)(g2 + c);
#pragma unroll
                for (int j = 0; j < 4; ++j) { const float yy = xv[j] + gv[j] * acc[q * 4 + j]; y[q * 4 + j] = yy; ss += yy * yy; } }
            ss = wave_sum(ss); const float rstd = rsqrtf(ss * (1.0f / 1024.0f) + 1e-6f);
#pragma unroll
            for (int q = 0; q < 4; ++q) { const int c = (q >> 1) * 512 + lane * 8 + (q & 1) * 4; const f32x4 fv = *(const f32x4*)(fg + c);
                f32x4 o; o[0] = y[q * 4] * rstd * fv[0]; o[1] = y[q * 4 + 1] * rstd * fv[1]; o[2] = y[q * 4 + 2] * rstd * fv[2]; o[3] = y[q * 4 + 3] * rstd * fv[3];
                *(f32x4*)(p.out + tok * 1024 + c) = o; }
        }
#endif
        __syncthreads();
    }
}
__global__ void __launch_bounds__(512, 2) mk_fwd(Params p, int lo, int hi) {
    extern __shared__ __attribute__((aligned(16))) unsigned char shm[];
    LAS unsigned char* lds = (LAS unsigned char*)shm;
    LAS unsigned char* L = lds + LDS_USER;
    const int bid = blockIdx.x, nb = gridDim.x, tid = threadIdx.x;
    unsigned char* ws = p.ws;
    const bool fused = (hi - lo) > 1;
    XcdBarrier bar; bar.bar = (unsigned*)ws; bar.x = 0; bar.st = (volatile LAS unsigned*)lds;
    if (fused) { if (tid == 0) { *(LAS u32x4*)lds = (u32x4){0u, 0u, 0u, 0u}; } __syncthreads(); bar = xcd_barrier_post((unsigned*)ws, (volatile LAS unsigned*)lds); }
    const float* mod = (const float*)(ws + OFF_MOD);
    bf16_t* Pm = (bf16_t*)(ws + OFF_P);
    unsigned char* outb = (unsigned char*)p.out;
#ifdef ONLY_PHASE
#define PHASE(k) if ((k) == ONLY_PHASE && lo <= (k) && (k) < hi)
#else
#define PHASE(k) if (lo <= (k) && (k) < hi)
#endif
#define SEAM(k) if (fused && lo <= (k) && (k) + 1 < hi) xcd_barrier(bar);
    PHASE(0) { phase_prologue(p, L, bid, nb); }
    SEAM(0)
    PHASE(1) { norm_rows(p.in[0], p.in[6], mod, 0, 1024, (bf16_t*)(outb + OUT_H1), bid, nb); }
    SEAM(1)
    PHASE(2) { pg8::Gemm g; g.A = (const bf16_t*)(outb + OUT_H1); g.Bt = (const bf16_t*)(ws + OFF_WIN); g.M = NTOK; g.N = NP; g.K = 1024;
        pg8::StaticOrder S; S.init(g.M, g.N, nb, bid); pg8::EpiStore16 E; E.O = Pm; E.ldc = NP;
        pg8::gemm_phase<pg8::EpiStore16, pg8::StaticOrder, false>(L, g, S, E, nullptr); }
    SEAM(2)
    PHASE(3) {
#ifndef NO_P3A
        dn_prep(p, L, bid, nb);
#endif
#ifndef NO_P3B
        for (int t = bid; t < 256; t += nb) compress_task(p, L, t);
#endif
#ifndef NO_P3C
        for (int u = bid; u < 2048; u += nb) vtrans_unit(p, L, u);
#endif
    }
    SEAM(3)
    PHASE(4) {
#ifndef NO_P4A
        for (int bh = bid; bh < 64; bh += nb) dn_scan(p, L, bh);
#endif
        unsigned* ctr = (unsigned*)(ws + OFF_CTR); LAS int* slot = (LAS int*)(lds + 32);
        for (;;) { if (tid == 0) *slot = (int)atomicAdd(ctr, 1u); __syncthreads(); const int u = *slot; __syncthreads(); if (u >= 1024) break;
#ifndef NO_P4B
            attn_unit(p, L, u);
#endif
        } }
    SEAM(4)
    PHASE(5) { pg8::Gemm g; g.A = (const bf16_t*)(outb + OUT_ONSA); g.Bt = (const bf16_t*)(ws + OFF_WN); g.M = NTOK; g.N = 1024; g.K = 512;
        pg8::StaticOrder S; S.init(g.M, g.N, nb, bid); pg8::EpiGate<false> E; E.O = (bf16_t*)(outb + OUT_MRG); E.ldc = 1024; E.G = Pm + CGN; E.ldg = NP;
        pg8::gemm_phase<pg8::EpiGate<false>, pg8::StaticOrder, false>(L, g, S, E, nullptr); }
    PHASE(6) { pg8::Gemm g; g.A = (const bf16_t*)(outb + OUT_ODN); g.Bt = (const bf16_t*)(ws + OFF_WD); g.M = NTOK; g.N = 1024; g.K = 512;
        pg8::StaticOrder S; S.init(g.M, g.N, nb, bid); pg8::EpiGate<true> E; E.O = (bf16_t*)(outb + OUT_MRG); E.ldc = 1024; E.G = Pm + CGD; E.ldg = NP;
        pg8::gemm_phase<pg8::EpiGate<true>, pg8::StaticOrder, false>(L, g, S, E, nullptr); }
    SEAM(6)
    PHASE(7) { pg8::Gemm g; g.A = (const bf16_t*)(outb + OUT_MRG); g.Bt = (const bf16_t*)(ws + OFF_WO); g.M = NTOK; g.N = 1024; g.K = 1024;
        pg8::StaticOrder S; S.init(g.M, g.N, nb, bid); pg8::EpiResid E; E.X = p.in[0]; E.O = (float*)(ws + OFF_X1); E.mod = mod; E.goff = 2048;
        pg8::gemm_phase<pg8::EpiResid, pg8::StaticOrder, false>(L, g, S, E, nullptr); }
    SEAM(7)
    PHASE(8) { norm_rows((const float*)(ws + OFF_X1), p.in[20], mod, 3072, 4096, (bf16_t*)(ws + OFF_H2), bid, nb);
        cvt_flat(p.in[24], (bf16_t*)(ws + OFF_UBF), (size_t)16384 * 1024, bid, nb); cvt_flat(p.in[25], (bf16_t*)(ws + OFF_VBF), (size_t)16384 * 1024, bid, nb); }
    SEAM(8)
    PHASE(9) { pg8::Gemm g; g.A = (const bf16_t*)(ws + OFF_H2); g.Bt = (const bf16_t*)(ws + OFF_WQ); g.M = NTOK; g.N = 1024; g.K = 1024;
        pg8::StaticOrder S; S.init(g.M, g.N, nb, bid); pg8::EpiStore16 E; E.O = (bf16_t*)(ws + OFF_QRY); E.ldc = 1024;
        pg8::gemm_phase<pg8::EpiStore16, pg8::StaticOrder, false>(L, g, S, E, nullptr); }
    SEAM(9)
    PHASE(10) { peer_phase(p, L, bid, nb); }
#undef PHASE
#undef SEAM
}
constexpr int N_PHASES = 11;
#ifndef MK_ONE_LAUNCH
#define MK_ONE_LAUNCH 0
#endif
extern "C" void kernel_launch(void* const* d_in, const int* in_sizes, int n_in, void* d_out, int out_size, void* d_ws, size_t ws_size, hipStream_t stream) {
    (void)in_sizes; (void)n_in; (void)out_size;
    static int grid = 0;
    if (!grid) {
        int dev = 0, cus = 0, per_cu = 0; hipGetDevice(&dev); hipDeviceGetAttribute(&cus, hipDeviceAttributeMultiprocessorCount, dev);
        hipFuncSetAttribute((const void*)mk_fwd, hipFuncAttributeMaxDynamicSharedMemorySize, LDS_BYTES);
        hipOccupancyMaxActiveBlocksPerMultiprocessor(&per_cu, (const void*)mk_fwd, 512, LDS_BYTES);
        if (per_cu < 1) { fprintf(stderr, "mk_fwd: occupancy query says 0 blocks per CU\n"); per_cu = 1; }
        grid = cus;
        if (ws_size < WS_NEED) fprintf(stderr, "mk_fwd: workspace too small (%zu < %zu)\n", ws_size, (size_t)WS_NEED);
    }
    hipMemsetAsync(d_ws, 0, 20480, stream);
    Params p{}; for (int i = 0; i < 26; ++i) p.in[i] = (const float*)d_in[i]; p.out = (float*)d_out; p.ws = (unsigned char*)d_ws;
#if MK_ONE_LAUNCH
    hipLaunchKernelGGL(mk_fwd, dim3(grid), dim3(512), LDS_BYTES, stream, p, 0, N_PHASES);
#else
    for (int k = 0; k < N_PHASES; ++k) hipLaunchKernelGGL(mk_fwd, dim3(grid), dim3(512), LDS_BYTES, stream, p, k, k + 1);
#endif
}
```

```cpp
#include <hip/hip_runtime.h>
#include <cstdio>
#include <cstdint>
#define MK_REP 0
namespace pg8 {
#define PG8_LAS __attribute__((address_space(3)))
typedef unsigned short bf16_t;
typedef short bf16x8 __attribute__((ext_vector_type(8)));
typedef float f32x4 __attribute__((ext_vector_type(4)));
typedef unsigned u32x4 __attribute__((ext_vector_type(4)));
constexpr int BM = 256, BK = 64, HALF = 128, HTB = HALF * BK * 2  , STAGE_BYTES = 8 * HTB, NXCD = 8, WGM = 4;

__host__ __device__ __forceinline__ int lds_byte(int r, int c) { const int st = (r >> 4) * 2 + (c >> 5), rr = r & 15, cc = c & 31, ob = rr * 64 + cc * 2; return st * 1024 + (ob ^ (((ob >> 9) & 1) << 5)); }
__host__ __device__ __forceinline__ void stage_rc(int b, int& R, int& C) { const int st = b / 1024, sb = b % 1024, swz = sb ^ (((sb >> 9) & 1) << 5); R = (st >> 1) * 16 + swz / 64; C = (st & 1) * 32 + (swz % 64) / 2; }
__host__ __device__ __forceinline__ int perm32(int rho) { const int n = rho >> 4, i = rho & 15; return 8 * (i >> 2) + 4 * n + (i & 3); }

struct Unit { int pm, pn; };
struct Gemm { const bf16_t* A; const bf16_t* Bt; int M, N, K; };

struct StaticOrder {
    int nM, nN, nwg, G, c;
    __host__ __device__ void init(int M, int N, int G_, int c_) { nM = M / BM; nN = N / BM; nwg = nM * nN; G = G_; c = c_; }
    __host__ __device__ bool next(int i, Unit& u) const {
        const long L = (long)i * G + c; if (L >= nwg) return false;
        int wgid = (int)L; { const int q = nwg / NXCD, r = nwg % NXCD, xcd = wgid % NXCD, off = wgid / NXCD; wgid = (xcd < r ? xcd * (q + 1) : r * (q + 1) + (xcd - r) * q) + off; }
        const int nig = WGM * nN, gid = wgid / nig, fm = gid * WGM, gsz = (nM - fm) < WGM ? (nM - fm) : WGM;
        u.pm = fm + ((wgid % nig) % gsz); u.pn = (wgid % nig) / gsz; return true;
    }
    __device__ __forceinline__ void a_ready(const Unit&) const {}
    __device__ __forceinline__ void done(const Unit&) const {}
};
__device__ __forceinline__ unsigned cvt_pk_bf16(float lo, float hi) { unsigned r; asm volatile("v_cvt_pk_bf16_f32 %0, %1, %2" : "=v"(r) : "v"(lo), "v"(hi)); return r; }
typedef float f32x2 __attribute__((ext_vector_type(2)));
struct EpiStore16 {
    static constexpr bool PERM = true, AFTER_DRAIN = false, IDEMP = true;
    bf16_t* O; int ldc;
    __device__ __forceinline__ void operator()(const f32x4 (&acc)[2][2][4][2], const Unit& u, int wr, int wc, int fr, int fq) const {
        const int row0 = u.pm * BM + wr * 64 + fr, col0 = u.pn * BM + wc * 32 + 8 * fq;
#pragma unroll
        for (int ai = 0; ai < 2; ++ai)
#pragma unroll
            for (int m = 0; m < 4; ++m) { bf16_t* rowp = O + (size_t)(row0 + ai * HALF + m * 16) * ldc + col0;
#pragma unroll
                for (int bj = 0; bj < 2; ++bj) { const f32x4 v0 = acc[ai][bj][m][0], v1 = acc[ai][bj][m][1];
                    u32x4 w; w.x = cvt_pk_bf16(v0[0], v0[1]); w.y = cvt_pk_bf16(v0[2], v0[3]); w.z = cvt_pk_bf16(v1[0], v1[1]); w.w = cvt_pk_bf16(v1[2], v1[3]);
                    *(u32x4*)(rowp + bj * HALF) = w; } }
    }
};
__device__ __forceinline__ float bfu_lo(unsigned w) { return __uint_as_float(w << 16); }
__device__ __forceinline__ float bfu_hi(unsigned w) { return __uint_as_float(w & 0xffff0000u); }
typedef __bf16 bf16v2e __attribute__((ext_vector_type(2)));
__device__ __forceinline__ unsigned pk2(float lo, float hi) { const f32x2 v = {lo, hi}; return __builtin_bit_cast(unsigned, __builtin_convertvector(v, bf16v2e)); }
__device__ __forceinline__ float sigm(float x) { return __builtin_amdgcn_rcpf(1.0f + __builtin_amdgcn_exp2f(-1.4426950408889634f * x)); }
template <bool ACCUM> struct EpiGate {
    static constexpr bool PERM = true, AFTER_DRAIN = false, IDEMP = false;
    bf16_t* O; int ldc; const bf16_t* G; int ldg;
    __device__ __forceinline__ void operator()(const f32x4 (&acc)[2][2][4][2], const Unit& u, int wr, int wc, int fr, int fq) const {
        const int row0 = u.pm * BM + wr * 64 + fr, col0 = u.pn * BM + wc * 32 + 8 * fq;
#pragma unroll
        for (int ai = 0; ai < 2; ++ai)
#pragma unroll
            for (int m = 0; m < 4; ++m) { const size_t row = (size_t)(row0 + ai * HALF + m * 16);
#pragma unroll
                for (int bj = 0; bj < 2; ++bj) { const f32x4 v0 = acc[ai][bj][m][0], v1 = acc[ai][bj][m][1];
                    const u32x4 gw = *(const u32x4*)(G + row * ldg + col0 + bj * HALF);
                    float r[8];
                    r[0] = sigm(bfu_lo(gw.x)) * v0[0]; r[1] = sigm(bfu_hi(gw.x)) * v0[1]; r[2] = sigm(bfu_lo(gw.y)) * v0[2]; r[3] = sigm(bfu_hi(gw.y)) * v0[3];
                    r[4] = sigm(bfu_lo(gw.z)) * v1[0]; r[5] = sigm(bfu_hi(gw.z)) * v1[1]; r[6] = sigm(bfu_lo(gw.w)) * v1[2]; r[7] = sigm(bfu_hi(gw.w)) * v1[3];
                    bf16_t* op = O + row * ldc + col0 + bj * HALF;
                    if (ACCUM) { const u32x4 ow = *(const u32x4*)op;
                        r[0] += bfu_lo(ow.x); r[1] += bfu_hi(ow.x); r[2] += bfu_lo(ow.y); r[3] += bfu_hi(ow.y); r[4] += bfu_lo(ow.z); r[5] += bfu_hi(ow.z); r[6] += bfu_lo(ow.w); r[7] += bfu_hi(ow.w); }
                    u32x4 w; w.x = cvt_pk_bf16(r[0], r[1]); w.y = cvt_pk_bf16(r[2], r[3]); w.z = cvt_pk_bf16(r[4], r[5]); w.w = cvt_pk_bf16(r[6], r[7]);
                    *(u32x4*)op = w; } }
    }
};
struct EpiResid {
    static constexpr bool PERM = true, AFTER_DRAIN = false, IDEMP = false;
    const float* X; bf16_t* O; const float* mod; int goff;
    __device__ __forceinline__ void operator()(const f32x4 (&acc)[2][2][4][2], const Unit& u, int wr, int wc, int fr, int fq) const {
        const int row0 = u.pm * BM + wr * 64 + fr, col0 = u.pn * BM + wc * 32 + 8 * fq;
        const float* gp = mod + (size_t)((u.pm * BM) >> 12) * 6144 + goff;
        f32x4 g[2][2];
#pragma unroll
        for (int bj = 0; bj < 2; ++bj) { g[bj][0] = *(const f32x4*)(gp + col0 + bj * HALF); g[bj][1] = *(const f32x4*)(gp + col0 + bj * HALF + 4); }
#pragma unroll
        for (int ai = 0; ai < 2; ++ai)
#pragma unroll
            for (int mh = 0; mh < 2; ++mh) {
                f32x4 x[2][2][2];
#pragma unroll
                for (int mm = 0; mm < 2; ++mm)
#pragma unroll
                    for (int bj = 0; bj < 2; ++bj) { const float* xp = X + (size_t)(row0 + ai * HALF + (2 * mh + mm) * 16) * 1024 + col0 + bj * HALF; x[mm][bj][0] = *(const f32x4*)xp; x[mm][bj][1] = *(const f32x4*)(xp + 4); }
#pragma unroll
                for (int mm = 0; mm < 2; ++mm)
#pragma unroll
                    for (int bj = 0; bj < 2; ++bj) { const int m = 2 * mh + mm; const size_t row = (size_t)(row0 + ai * HALF + m * 16);
                        const f32x4 r0 = x[mm][bj][0] + g[bj][0] * acc[ai][bj][m][0], r1 = x[mm][bj][1] + g[bj][1] * acc[ai][bj][m][1];
                        u32x4 w; w.x = cvt_pk_bf16(r0[0], r0[1]); w.y = cvt_pk_bf16(r0[2], r0[3]); w.z = cvt_pk_bf16(r1[0], r1[1]); w.w = cvt_pk_bf16(r1[2], r1[3]);
                        *(u32x4*)(O + row * 1024 + col0 + bj * HALF) = w; }
            }
    }
};
struct PairOrder : StaticOrder {
    __host__ __device__ bool next(int i, Unit& u) const {
        const long L = (long)i * G + c; if (L >= 2 * nwg) return false;
        const int half = L >= nwg ? 1 : 0; int wgid = (int)(L - (long)half * nwg);
        { const int q = nwg / NXCD, r = nwg % NXCD, xcd = wgid % NXCD, off = wgid / NXCD; wgid = (xcd < r ? xcd * (q + 1) : r * (q + 1) + (xcd - r) * q) + off; }
        const int nig = WGM * nN, gid = wgid / nig, fm = gid * WGM, gsz = (nM - fm) < WGM ? (nM - fm) : WGM;
        u.pm = fm + ((wgid % nig) % gsz) + half * nM; u.pn = (wgid % nig) / gsz + half * nN; return true;
    }
};
struct EpiGatePair {
    static constexpr bool PERM = true, AFTER_DRAIN = false, IDEMP = false;
    bf16_t* O; int ldc; const bf16_t* G0; const bf16_t* G1; int ldg; int nM, nN;
    __device__ __forceinline__ void operator()(const f32x4 (&acc)[2][2][4][2], const Unit& u, int wr, int wc, int fr, int fq) const {
        if (u.pn >= nN) { Unit v; v.pm = u.pm - nM; v.pn = u.pn - nN; EpiGate<true> e; e.O = O; e.ldc = ldc; e.G = G1; e.ldg = ldg; e(acc, v, wr, wc, fr, fq); }
        else { EpiGate<false> e; e.O = O; e.ldc = ldc; e.G = G0; e.ldg = ldg; e(acc, u, wr, wc, fr, fq); }
    }
};
struct EpiInproj {
    static constexpr bool PERM = true, AFTER_DRAIN = false, IDEMP = true;
    bf16_t* O; int ldc; bf16_t* GT;
    __device__ __forceinline__ void operator()(const f32x4 (&acc)[2][2][4][2], const Unit& u, int wr, int wc, int fr, int fq) const {
        if (u.pn >= 13 && u.pn < 21) {
            bf16_t* gp = GT + ((size_t)(u.pm * 8 + (u.pn - 13)) * 8192 + (size_t)(wr * 4 + wc) * 1024 + (fq * 16 + fr)) * 8;
#pragma unroll
            for (int ai = 0; ai < 2; ++ai)
#pragma unroll
                for (int m = 0; m < 4; ++m)
#pragma unroll
                    for (int bj = 0; bj < 2; ++bj) { const f32x4 v0 = acc[ai][bj][m][0], v1 = acc[ai][bj][m][1];
                        u32x4 w; w.x = pk2(sigm(v0[0]), sigm(v0[1])); w.y = pk2(sigm(v0[2]), sigm(v0[3])); w.z = pk2(sigm(v1[0]), sigm(v1[1])); w.w = pk2(sigm(v1[2]), sigm(v1[3]));
                        *(u32x4*)(gp + (size_t)(((ai * 4 + m) * 2 + bj) * 64) * 8) = w; }
        } else {
            Unit v = u; if (u.pn == 21) v.pn = 13;
            EpiStore16 e; e.O = O; e.ldc = ldc; e(acc, v, wr, wc, fr, fq);
        }
    }
};
struct EpiGateFrag {
    static constexpr bool PERM = true, AFTER_DRAIN = false, IDEMP = false;
    bf16_t* O; int ldc; const bf16_t* GT; int nM, nN;
    __device__ __forceinline__ void operator()(const f32x4 (&acc)[2][2][4][2], const Unit& u, int wr, int wc, int fr, int fq) const {
        const bool second = u.pn >= nN; const int pm = second ? u.pm - nM : u.pm, pn = second ? u.pn - nN : u.pn;
        const bf16_t* gp = GT + ((size_t)(pm * 8 + pn + (second ? 4 : 0)) * 8192 + (size_t)(wr * 4 + wc) * 1024 + (fq * 16 + fr)) * 8;
        const int row0 = pm * BM + wr * 64 + fr, col0 = pn * BM + wc * 32 + 8 * fq;
#pragma unroll
        for (int ai = 0; ai < 2; ++ai) {
            u32x4 gw[4][2], ow[4][2];
#pragma unroll
            for (int m = 0; m < 4; ++m)
#pragma unroll
                for (int bj = 0; bj < 2; ++bj) { gw[m][bj] = *(const u32x4*)(gp + (size_t)(((ai * 4 + m) * 2 + bj) * 64) * 8);
                    ow[m][bj] = (u32x4){0u, 0u, 0u, 0u};
                    if (second) ow[m][bj] = *(const u32x4*)(O + (size_t)(row0 + ai * HALF + m * 16) * ldc + col0 + bj * HALF); }
#pragma unroll
            for (int m = 0; m < 4; ++m) { const size_t row = (size_t)(row0 + ai * HALF + m * 16);
#pragma unroll
                for (int bj = 0; bj < 2; ++bj) { const f32x4 v0 = acc[ai][bj][m][0], v1 = acc[ai][bj][m][1]; const u32x4 g = gw[m][bj], o = ow[m][bj];
                    float r[8];
                    r[0] = bfu_lo(g.x) * v0[0] + bfu_lo(o.x); r[1] = bfu_hi(g.x) * v0[1] + bfu_hi(o.x); r[2] = bfu_lo(g.y) * v0[2] + bfu_lo(o.y); r[3] = bfu_hi(g.y) * v0[3] + bfu_hi(o.y);
                    r[4] = bfu_lo(g.z) * v1[0] + bfu_lo(o.z); r[5] = bfu_hi(g.z) * v1[1] + bfu_hi(o.z); r[6] = bfu_lo(g.w) * v1[2] + bfu_lo(o.w); r[7] = bfu_hi(g.w) * v1[3] + bfu_hi(o.w);
                    u32x4 w; w.x = cvt_pk_bf16(r[0], r[1]); w.y = cvt_pk_bf16(r[2], r[3]); w.z = cvt_pk_bf16(r[4], r[5]); w.w = cvt_pk_bf16(r[6], r[7]);
                    *(u32x4*)(O + row * ldc + col0 + bj * HALF) = w; } }
        }
    }
};
template <class Epi, class Sched, bool STAMP = false>
__device__ __forceinline__ void gemm_phase(PG8_LAS unsigned char* lds, const Gemm g, const Sched& S, const Epi& E, unsigned long long* stamps) {
    const int tid = threadIdx.x, wid = __builtin_amdgcn_readfirstlane(tid >> 6), lane = tid & 63, wr = wid >> 2, wc = wid & 3, fr = lane & 15, fq = lane >> 4;
    const int K = g.K, nt = K / BK;
    int ts_lo = 0, ts_hi = 0, nts = 0; const unsigned long long rt_entry = STAMP ? (unsigned long long)wall_clock64() : 0ull;
#define PG8_STAMP() do { if (STAMP && wid == 0 && nts < 64) { const unsigned long long _c = (unsigned long long)clock64(); \
        ts_lo = (lane == nts) ? (int)(unsigned)_c : ts_lo; ts_hi = (lane == nts) ? (int)(unsigned)(_c >> 32) : ts_hi; ++nts; } } while (0)
    PG8_STAMP();
    unsigned voffA[2], voffB[2];
#pragma unroll
    for (int i = 0; i < 2; ++i) { int R, C; stage_rc(tid * 16 + i * 8192, R, C); const int Rb = Epi::PERM ? ((R & ~31) + perm32(R & 31)) : R;
        voffA[i] = (unsigned)(R * K + C) * 2u; voffB[i] = (unsigned)(Rb * K + C) * 2u; }
    const size_t kstep = (size_t)(BK * 2);
    const size_t hstep = (size_t)HALF * K * 2;
    const size_t tstep = 2 * hstep;
    const unsigned ldsw = (unsigned)wid * 1024u;
    const int aoff = lds_byte(wr * 64 + fr, fq * 8), boff = lds_byte(wc * 32 + fr, fq * 8);
#define PG8_SA(b, h) (((b) * 2 + (h)) * HTB)
#define PG8_SB(b, h) ((4 + (b) * 2 + (h)) * HTB)
#define PG8_STAGE(bufoff, gbase, voff) do { _Pragma("unroll") for (int _i = 0; _i < 2; ++_i) \
        __builtin_amdgcn_global_load_lds((const unsigned*)((const char*)(gbase) + (voff)[_i]), (PG8_LAS unsigned*)(lds + (bufoff) + ldsw + _i * 8192), 16, 0, 0); } while (0)
#define PG8_LDA(dst, b, h) do { _Pragma("unroll") for (int m = 0; m < 4; ++m) _Pragma("unroll") for (int k = 0; k < 2; ++k) dst[m][k] = *(const PG8_LAS bf16x8*)(lds + PG8_SA(b, h) + aoff + m * 2048 + k * 1024); } while (0)
#define PG8_LDB(dst, b, h) do { _Pragma("unroll") for (int n = 0; n < 2; ++n) _Pragma("unroll") for (int k = 0; k < 2; ++k) dst[n][k] = *(const PG8_LAS bf16x8*)(lds + PG8_SB(b, h) + boff + n * 2048 + k * 1024); } while (0)
#define PG8_MMA(ai, bj, At, Bt) do { __builtin_amdgcn_s_setprio(1); _Pragma("unroll") for (int m = 0; m < 4; ++m) _Pragma("unroll") for (int n = 0; n < 2; ++n) _Pragma("unroll") for (int k = 0; k < 2; ++k) \
        acc[ai][bj][m][n] = __builtin_amdgcn_mfma_f32_16x16x32_bf16(Bt[n][k], At[m][k], acc[ai][bj][m][n], 0, 0, 0); __builtin_amdgcn_s_setprio(0); } while (0)
#define PG8_WAIT_V(n) asm volatile("s_waitcnt vmcnt(" #n ")" ::: "memory")
#define PG8_WAIT_L(n) asm volatile("s_waitcnt lgkmcnt(" #n ")" ::: "memory")
#define PG8_BAR __builtin_amdgcn_s_barrier()
#define PG8_SCHED __builtin_amdgcn_sched_barrier(0)
    Unit cur, nxt; int ui = 0;
    if (!S.next(0, cur)) return;
    f32x4 acc[2][2][4][2];
#pragma unroll
    for (int a = 0; a < 2; ++a)
#pragma unroll
        for (int b = 0; b < 2; ++b)
#pragma unroll
            for (int m = 0; m < 4; ++m)
#pragma unroll
                for (int n = 0; n < 2; ++n) acc[a][b][m][n] = (f32x4){0.f, 0.f, 0.f, 0.f};
    bf16x8 At[4][2], B0[2][2], B1[2][2];
    const char* cA = (const char*)g.A + (size_t)cur.pm * tstep; const char* cB = (const char*)g.Bt + (size_t)cur.pn * tstep;
    S.a_ready(cur);
    PG8_STAGE(PG8_SB(0, 0), cB, voffB); PG8_STAGE(PG8_SA(0, 0), cA, voffA); PG8_STAGE(PG8_SB(0, 1), cB + hstep, voffB); PG8_STAGE(PG8_SA(0, 1), cA + hstep, voffA);
    if (wr == 1) PG8_BAR;
    PG8_WAIT_V(4); PG8_BAR;
    PG8_STAGE(PG8_SB(1, 0), cB + kstep, voffB); PG8_STAGE(PG8_SA(1, 0), cA + kstep, voffA); PG8_STAGE(PG8_SB(1, 1), cB + hstep + kstep, voffB);
    PG8_WAIT_V(6); PG8_BAR;
    PG8_STAMP();
    for (;;) {
        const bool has_next = S.next(ui + 1, nxt);
        const char* nA = has_next ? (const char*)g.A + (size_t)nxt.pm * tstep : cA; const char* nB = has_next ? (const char*)g.Bt + (size_t)nxt.pn * tstep : cB;
        for (int t = 0; t < nt; t += 2) {
            const bool last = (t == nt - 2);
            const char* a1 = cA + (size_t)(t + 1) * kstep;
            const char* a2 = last ? nA : cA + (size_t)(t + 2) * kstep; const char* b2 = last ? nB : cB + (size_t)(t + 2) * kstep;
            const char* a3 = a2 + kstep; const char* b3 = b2 + kstep;
            if (last && has_next) S.a_ready(nxt);
            PG8_LDB(B0, 0, 0); PG8_SCHED; PG8_LDA(At, 0, 0); PG8_STAGE(PG8_SA(1, 1), a1 + hstep, voffA);
            PG8_WAIT_L(8); PG8_BAR; PG8_WAIT_L(0); PG8_MMA(0, 0, At, B0); PG8_BAR; PG8_SCHED;
            PG8_LDB(B1, 0, 1); PG8_STAGE(PG8_SB(0, 0), b2, voffB);
            PG8_BAR; PG8_WAIT_L(0); PG8_MMA(0, 1, At, B1); PG8_BAR;
            PG8_LDA(At, 0, 1); PG8_STAGE(PG8_SA(0, 0), a2, voffA);
            PG8_BAR; PG8_WAIT_L(0); PG8_MMA(1, 0, At, B0); PG8_BAR; PG8_SCHED;
            PG8_STAGE(PG8_SB(0, 1), b2 + hstep, voffB);
            PG8_WAIT_V(6); PG8_BAR; PG8_MMA(1, 1, At, B1); PG8_BAR;
            PG8_LDB(B0, 1, 0); PG8_SCHED; PG8_LDA(At, 1, 0); PG8_STAGE(PG8_SA(0, 1), a2 + hstep, voffA);
            PG8_WAIT_L(8); PG8_BAR; PG8_WAIT_L(0); PG8_MMA(0, 0, At, B0); PG8_BAR; PG8_SCHED;
            PG8_LDB(B1, 1, 1); PG8_STAGE(PG8_SB(1, 0), b3, voffB);
            PG8_BAR; PG8_WAIT_L(0); PG8_MMA(0, 1, At, B1); PG8_BAR;
            PG8_LDA(At, 1, 1); PG8_STAGE(PG8_SA(1, 0), a3, voffA);
            PG8_BAR; PG8_WAIT_L(0); PG8_MMA(1, 0, At, B0); PG8_BAR; PG8_SCHED;
            PG8_STAGE(PG8_SB(1, 1), b3 + hstep, voffB);
            PG8_WAIT_V(6); PG8_BAR; PG8_MMA(1, 1, At, B1); PG8_BAR;
        }
        PG8_STAMP();
        if constexpr (!Epi::AFTER_DRAIN) { E(acc, cur, wr, wc, fr, fq);
#if (MK_REP >> 25) & 1
            if constexpr (Epi::IDEMP) E(acc, cur, wr, wc, fr, fq);
#endif
            S.done(cur); }
        PG8_STAMP();
        if (!has_next) break;
#pragma unroll
        for (int a = 0; a < 2; ++a)
#pragma unroll
            for (int b = 0; b < 2; ++b)
#pragma unroll
                for (int m = 0; m < 4; ++m)
#pragma unroll
                    for (int n = 0; n < 2; ++n) acc[a][b][m][n] = (f32x4){0.f, 0.f, 0.f, 0.f};
        cur = nxt; cA = nA; cB = nB; ++ui;
    }
    PG8_WAIT_V(0);
    if (wr == 0) PG8_BAR;
    PG8_BAR;
    if constexpr (Epi::AFTER_DRAIN) { E.fused(acc, cur, wr, wc, fr, fq, lds, wid, lane); S.done(cur); }
    PG8_STAMP();
    if (STAMP && wid == 0) { stamps[lane] = lane < nts ? (((unsigned long long)(unsigned)ts_hi << 32) | (unsigned)ts_lo) : 0ull;
        if (lane == 62) stamps[62] = rt_entry; if (lane == 63) stamps[63] = (unsigned long long)wall_clock64(); }
#undef PG8_STAMP
#undef PG8_SA
#undef PG8_SB
#undef PG8_STAGE
#undef PG8_LDA
#undef PG8_LDB
#undef PG8_MMA
#undef PG8_WAIT_V
#undef PG8_WAIT_L
#undef PG8_BAR
#undef PG8_SCHED
}
}
#define XB_TMO      128
#define XB_XCNT(j)  (256  + 64 * (j))
#define XB_XSUB(j)  (1280 + 64 * (j))
#define XB_XGEN(j)  (2304 + 64 * (j))
#define XB_TOP      3328
#define XB_TOPGEN   3392
#define XCD_BAR_WORDS 3456
#define XB_SPIN_CAP (1u << 18)
#define LAS __attribute__((address_space(3)))

__device__ __forceinline__ unsigned xb_ld(unsigned* p)              { return __hip_atomic_load(p, __ATOMIC_RELAXED, __HIP_MEMORY_SCOPE_AGENT); }
__device__ __forceinline__ unsigned xb_add(unsigned* p, unsigned v) { return __hip_atomic_fetch_add(p, v, __ATOMIC_RELAXED, __HIP_MEMORY_SCOPE_AGENT); }
__device__ __forceinline__ unsigned xb_xcc_id() { return (unsigned)__builtin_amdgcn_s_getreg((3 << 11) | 20) & 0xFu; }
#define XB_SPIN(cond, bar) do { unsigned _sp = 0; while (cond) { __builtin_amdgcn_s_sleep(1); \
    if ((++_sp & 255u) == 0u) { if (xb_ld(&(bar)[XB_TMO])) break; if (_sp > XB_SPIN_CAP) { atomicAdd(&(bar)[XB_TMO], 1u); break; } } } } while (0)

struct XcdBarrier {
    unsigned* bar; unsigned x;
    volatile LAS unsigned* st;
};

__device__ __forceinline__ XcdBarrier xcd_barrier_post(unsigned* bar, volatile LAS unsigned* st) {
    XcdBarrier b; b.bar = bar; b.x = xb_xcc_id(); b.st = st;
    if (threadIdx.x == 0) (void)xb_add(&bar[XB_XCNT(b.x)], 1u);
    return b;
}
__device__ __forceinline__ void xcd_barrier_complete(unsigned* bar, unsigned x, unsigned& nloc, unsigned& nx) {
    const unsigned G = gridDim.x * gridDim.y * gridDim.z;
    unsigned sum, cnt, mine, sp = 0u;
    for (;;) {
        sum = 0u; cnt = 0u; mine = 0u;
#pragma unroll
        for (unsigned j = 0; j < 16; ++j) { const unsigned c = xb_ld(&bar[XB_XCNT(j)]); sum += c; cnt += (c > 0u) ? 1u : 0u; mine = (j == x) ? c : mine; }
        if (sum == G) break;
        __builtin_amdgcn_s_sleep(1);
        if ((++sp & 255u) == 0u) { if (xb_ld(&bar[XB_TMO])) break; if (sp > XB_SPIN_CAP) { atomicAdd(&bar[XB_TMO], 1u); break; } }
    }
    nloc = mine > 0u ? mine : 1u; nx = cnt > 0u ? cnt : 1u;
}

__device__ __forceinline__ void xcd_barrier(const XcdBarrier& b) {
    asm volatile("s_waitcnt vmcnt(0)" ::: "memory");
    __syncthreads();
    if (threadIdx.x == 0) {
        unsigned* bar = b.bar;
        __builtin_amdgcn_s_waitcnt(0);
        unsigned nloc = b.st[0], nx = b.st[1];
        if (nloc == 0u) { xcd_barrier_complete(bar, b.x, nloc, nx); b.st[0] = nloc; b.st[1] = nx; }
        const unsigned old = xb_add(&bar[XB_XSUB(b.x)], 1u);
        const unsigned gen = old / nloc;
        if (old + 1u == (gen + 1u) * nloc) {
            __builtin_amdgcn_fence(__ATOMIC_RELEASE, "agent");
            asm volatile("s_waitcnt vmcnt(0)" ::: "memory");
            const unsigned og = xb_add(&bar[XB_TOP], 1u);
            const unsigned tg = og / nx;
            if (og + 1u == (tg + 1u) * nx) xb_add(&bar[XB_TOPGEN], 1u);
            else XB_SPIN(xb_ld(&bar[XB_TOPGEN]) == tg, bar);
            __builtin_amdgcn_fence(__ATOMIC_ACQUIRE, "agent");
            xb_add(&bar[XB_XGEN(b.x)], 1u);
            asm volatile("s_waitcnt vmcnt(0)" ::: "memory");
        } else {
            XB_SPIN(xb_ld(&bar[XB_XGEN(b.x)]) == gen, bar);
            __builtin_amdgcn_fence(__ATOMIC_ACQUIRE, "agent");
            asm volatile("s_waitcnt vmcnt(0)" ::: "memory");
        }
    }
    __syncthreads();
}
#ifndef MK_REP
#define MK_REP 0
#endif
#define DI __device__ __forceinline__
typedef unsigned short bf16_t;
typedef short bf16x8 __attribute__((ext_vector_type(8)));
typedef float f32x4 __attribute__((ext_vector_type(4)));
typedef float f32x16 __attribute__((ext_vector_type(16)));
typedef unsigned u32x4 __attribute__((ext_vector_type(4)));
typedef unsigned u32x2 __attribute__((ext_vector_type(2)));

constexpr int NTOK = 32768, DM = 1024, SEQ = 4096;
constexpr int NGEMM = 5632;
constexpr int NP = 3584;
constexpr int CQ = 0, CKC = 512, CVC = 640, CKS = 768, CVS = 896, CKW = 1024, CVW = 1152, CDQ = 1280, CDK = 1792, CDV = 2304, CZ = 2816, CNG = 3328, CB = 3352, CA = 3360;
constexpr size_t OFF_CTR = 16384, OFF_MOD = 20480, OFF_C1 = 217088, OFF_BTAB = 217600, OFF_GL = 221696;
constexpr size_t OFF_WIN = 262144, OFF_WN = 11796480, OFF_WD = 12845056, OFF_WO = 13893632, OFF_WQ = 15990784;
constexpr size_t OFF_W1K = 18087936, OFF_W1V = 18350080, OFF_W2K = 18612224, OFF_W2V = 18620416, OFF_KEYS = 18628608;
constexpr size_t OFF_KC = 18890752, OFF_VCT = 19415040, OFF_VTS = 19939328, OFF_VTW = 28327936;
constexpr size_t OFF_P = 37748736;
constexpr size_t OFF_GATES = OFF_P + (size_t)NTOK * NP * 2;
constexpr size_t OFF_WF = 406847488, OFF_UF = OFF_WF + 33554432, OFF_AF = OFF_UF + 33554432;
constexpr size_t WS_NEED = OFF_AF + 33554432;
constexpr size_t OFF_X1 = OFF_P, OFF_H2 = OFF_P + 134217728, OFF_QRY = OFF_H2 + 67108864, OFF_UBF = OFF_QRY + 67108864, OFF_VBF = OFF_UBF + 33554432, OFF_USC = OFF_UBF + 16777216;
constexpr size_t OUT_H1 = 0, OUT_QF = 0, OUT_KF = 33554432, OUT_MRG = 0, OUT_ONSA = 67108864, OUT_ODN = 100663296;
constexpr int LDS_BYTES = 147456, LDS_USER = 256;

struct Params { const float* in[26]; float* out; unsigned char* ws; };

DI float bf2f(bf16_t b) { return __uint_as_float(((unsigned)b) << 16); }
DI float blo(unsigned w) { return __uint_as_float(w << 16); }
DI float bhi(unsigned w) { return __uint_as_float(w & 0xffff0000u); }
DI bf16_t f2bf(float f) { unsigned u = __float_as_uint(f); u += 0x7FFFu + ((u >> 16) & 1u); return (bf16_t)(u >> 16); }
typedef __bf16 bf16v2_t __attribute__((ext_vector_type(2)));
typedef float f32x2 __attribute__((ext_vector_type(2)));
DI unsigned pack2(float lo, float hi) { const f32x2 v = {lo, hi}; return __builtin_bit_cast(unsigned, __builtin_convertvector(v, bf16v2_t)); }
DI bf16x8 pack8(const f32x16& v, int s) {
    u32x4 p; p.x = pack2(v[8 * s], v[8 * s + 1]); p.y = pack2(v[8 * s + 2], v[8 * s + 3]); p.z = pack2(v[8 * s + 4], v[8 * s + 5]); p.w = pack2(v[8 * s + 6], v[8 * s + 7]);
    return __builtin_bit_cast(bf16x8, p);
}
DI f32x16 zero16() { f32x16 z;
#pragma unroll
    for (int i = 0; i < 16; ++i) z[i] = 0.f; return z; }
#define MFMA32(a, b, c) __builtin_amdgcn_mfma_f32_32x32x16_bf16((a), (b), (c), 0, 0, 0)
DI int crow(int r, int hh) { return 8 * (r >> 2) + 4 * hh + (r & 3); }
DI float wave_sum(float v) { v += __shfl_xor(v, 32); v += __shfl_xor(v, 16); v += __shfl_xor(v, 8); v += __shfl_xor(v, 4); v += __shfl_xor(v, 2); v += __shfl_xor(v, 1); return v; }
DI float sigmf(float x) { return __builtin_amdgcn_rcpf(1.0f + __builtin_amdgcn_exp2f(-1.4426950408889634f * x)); }
DI float siluf(float x) { return x * sigmf(x); }
DI float gelu_tanh(float x) { const float u = 0.7978845608028654f * (x + 0.044715f * x * x * x); return x * sigmf(2.0f * u); }
DI int vperm16(int j) { return (j & 3) + 4 * (j >> 3) + 8 * ((j >> 2) & 1); }

DI int winmap(int n) {
    if (n < 1280) return n;
    if (n < 3328) return n + 24;
    if (n < 5376) return n + 40;
    if (n < 5400) return n - 5376 + 1280;
    if (n < 5408) return n - 5400 + 3352;
    if (n < 5416) return n - 5408 + 3360;
    return -1;
}
DI void cvt_tile(const float* src, int ld, bf16_t* dst, int K, int kt, int nt, bool usemap, LAS float* T) {
    const int tid = threadIdx.x;
    { const int r = tid >> 4, c4 = (tid & 15) * 4;
#pragma unroll
      for (int ps = 0; ps < 2; ++ps) { const int k = kt * 64 + r + 32 * ps, n = nt * 64 + c4; const int sc = usemap ? winmap(n) : n;
          f32x4 v = (f32x4){0.f, 0.f, 0.f, 0.f}; if (sc >= 0) v = *(const f32x4*)(src + (size_t)k * ld + sc);
          LAS float* tp = T + (r + 32 * ps) * 65 + c4; tp[0] = v[0]; tp[1] = v[1]; tp[2] = v[2]; tp[3] = v[3]; } }
    __syncthreads();
    { const int n = tid >> 3, kc = (tid & 7) * 8; float v[8];
#pragma unroll
      for (int j = 0; j < 8; ++j) v[j] = T[(kc + j) * 65 + n];
      u32x4 w; w.x = pack2(v[0], v[1]); w.y = pack2(v[2], v[3]); w.z = pack2(v[4], v[5]); w.w = pack2(v[6], v[7]);
      *(u32x4*)(dst + (size_t)(nt * 64 + n) * K + kt * 64 + kc) = w; }
    __syncthreads();
}
DI void cvt_flat(const float* src, bf16_t* dst, size_t n, int bid, int nb) {
    for (size_t i = ((size_t)bid * 512 + threadIdx.x) * 8; i < n; i += (size_t)nb * 512 * 8) {
        const f32x4 a = *(const f32x4*)(src + i), b = *(const f32x4*)(src + i + 4);
        u32x4 w; w.x = pack2(a[0], a[1]); w.y = pack2(a[2], a[3]); w.z = pack2(b[0], b[1]); w.w = pack2(b[2], b[3]);
        *(u32x4*)(dst + i) = w; }
}
DI void cvt_fp8(const float* src, unsigned char* dst, size_t n, float scale, int bid, int nb) {
    for (size_t i = ((size_t)bid * 512 + threadIdx.x) * 16; i < n; i += (size_t)nb * 512 * 16) {
        u32x4 w;
#pragma unroll
        for (int q = 0; q < 4; ++q) { const f32x4 a = *(const f32x4*)(src + i + 4 * q) * scale;
            int v = __builtin_amdgcn_cvt_pk_fp8_f32(a[0], a[1], 0, false); v = __builtin_amdgcn_cvt_pk_fp8_f32(a[2], a[3], v, true); w[q] = (unsigned)v; }
        *(u32x4*)(dst + i) = w; }
}
DI void cvt_i8_rows(const float* src, unsigned char* dst, float* scale, int nrows, int bid, int nb) {
    const int wave = threadIdx.x >> 6, lane = threadIdx.x & 63;
    for (int row = bid * 8 + wave; row < nrows; row += nb * 8) {
        const float* sp = src + (size_t)row * 1024 + lane * 16; f32x4 v[4]; float am = 0.f;
#pragma unroll
        for (int q = 0; q < 4; ++q) { v[q] = *(const f32x4*)(sp + 4 * q); am = fmaxf(am, fmaxf(fmaxf(fabsf(v[q][0]), fabsf(v[q][1])), fmaxf(fabsf(v[q][2]), fabsf(v[q][3])))); }
#pragma unroll
        for (int o = 32; o >= 1; o >>= 1) am = fmaxf(am, __shfl_xor(am, o));
        const float sc = am > 0.f ? 127.0f / am : 0.f;
        u32x4 w;
#pragma unroll
        for (int q = 0; q < 4; ++q) { const int b0 = (int)rintf(v[q][0] * sc), b1 = (int)rintf(v[q][1] * sc), b2 = (int)rintf(v[q][2] * sc), b3 = (int)rintf(v[q][3] * sc);
            w[q] = (unsigned)(b0 & 0xFF) | ((unsigned)(b1 & 0xFF) << 8) | ((unsigned)(b2 & 0xFF) << 16) | ((unsigned)(b3 & 0xFF) << 24); }
        *(u32x4*)(dst + (size_t)row * 1024 + lane * 16) = w;
        if (lane == 0) scale[row] = am * (1.0f / 127.0f);
    }
}
DI void phase_prologue(const Params& p, LAS unsigned char* L, int bid, int nb) {
    const int tid = threadIdx.x;
    unsigned char* ws = p.ws;
    for (int cb = bid; cb < 192; cb += nb) {
        LAS float* cond = (LAS float*)L; LAS float* red = (LAS float*)(L + 32768);
        for (int i = tid; i < 8192; i += 512) cond[i] = siluf(p.in[1][i]);
        __syncthreads();
        const int cl = tid & 31, ks = tid >> 5, n = cb * 32 + cl;
        const float* w = p.in[4] + (size_t)(ks * 64) * 6144 + n;
        float acc[8];
#pragma unroll
        for (int b = 0; b < 8; ++b) acc[b] = 0.f;
        for (int k = 0; k < 64; ++k) { const float wv = w[(size_t)k * 6144];
#pragma unroll
            for (int b = 0; b < 8; ++b) acc[b] += cond[b * 1024 + ks * 64 + k] * wv; }
#pragma unroll
        for (int b = 0; b < 8; ++b) red[(ks * 8 + b) * 32 + cl] = acc[b];
        __syncthreads();
        if (tid < 256) { const int b = tid >> 5, c2 = tid & 31; float s = p.in[5][cb * 32 + c2];
            for (int k2 = 0; k2 < 16; ++k2) s += red[(k2 * 8 + b) * 32 + c2];
            ((float*)(ws + OFF_MOD))[b * 6144 + cb * 32 + c2] = s; }
        __syncthreads();
    }
    for (int t = bid; t < 2242; t += nb) {
        LAS float* T = (LAS float*)L;
        if (t < 1408) cvt_tile(p.in[7], 5416, (bf16_t*)(ws + OFF_WIN), 1024, t / 88, t % 88, true, T);
        else if (t < 1536) { const int u = t - 1408; cvt_tile(p.in[17], 1024, (bf16_t*)(ws + OFF_WN), 512, u / 16, u % 16, false, T); }
        else if (t < 1664) { const int u = t - 1536; cvt_tile(p.in[18], 1024, (bf16_t*)(ws + OFF_WD), 512, u / 16, u % 16, false, T); }
        else if (t < 1920) { const int u = t - 1664; cvt_tile(p.in[19], 1024, (bf16_t*)(ws + OFF_WO), 1024, u / 16, u % 16, false, T); }
        else if (t < 2176) { const int u = t - 1920; cvt_tile(p.in[21], 1024, (bf16_t*)(ws + OFF_WQ), 1024, u / 16, u % 16, false, T); }
        else if (t < 2208) { const int u = t - 2176; cvt_tile(p.in[9], 64, (bf16_t*)(ws + OFF_W1K), 2048, u, 0, false, T); }
        else if (t < 2240) { const int u = t - 2208; cvt_tile(p.in[11], 64, (bf16_t*)(ws + OFF_W1V), 2048, u, 0, false, T); }
        else if (t == 2240) cvt_tile(p.in[10], 64, (bf16_t*)(ws + OFF_W2K), 64, 0, 0, false, T);
        else cvt_tile(p.in[12], 64, (bf16_t*)(ws + OFF_W2V), 64, 0, 0, false, T);
    }
    cvt_flat(p.in[22], (bf16_t*)(ws + OFF_KEYS), 65536, bid, nb);
    cvt_flat(p.in[23], (bf16_t*)(ws + OFF_KEYS) + 65536, 65536, bid, nb);
    for (int wch = 0; wch < 2; ++wch) if (bid == (200 + wch) % nb) {
        LAS float* red = (LAS float*)L; const float* w1 = p.in[wch ? 11 : 9]; const float* pos = p.in[8];
        const int j = tid & 63, ks = tid >> 6; float s = 0.f;
        for (int e = ks * 256; e < ks * 256 + 256; ++e) s += pos[e] * w1[(size_t)e * 64 + j];
        red[ks * 64 + j] = s; __syncthreads();
        if (tid < 64) { float t2 = 0.f; for (int k2 = 0; k2 < 8; ++k2) t2 += red[k2 * 64 + tid]; ((float*)(ws + OFF_C1))[wch * 64 + tid] = t2; }
        __syncthreads();
    }
    if (bid == 202 % nb) {
        for (int i = tid; i < 1024; i += 512) { const int h = i >> 7, d = i & 127; int bk;
            if (d < 16) bk = d; else { const float sc = logf((float)d / 16.0f) / logf(8.0f); bk = 16 + (int)(sc * 16.0f); if (bk > 31) bk = 31; }
            ((float*)(ws + OFF_BTAB))[i] = p.in[2][bk * 8 + h]; }
    }
}
template <bool SRC_BF16>
DI void norm_rows(const void* srcv, const float* g, const float* mod, int shoff, int scoff, bf16_t* dst, int bid, int nb) {
    const int wave = threadIdx.x >> 6, lane = threadIdx.x & 63;
    for (int t0 = (bid * 8 + wave) * 16; t0 < NTOK; t0 += nb * 8 * 16) {
        const float* mb = mod + (size_t)(t0 >> 12) * 6144;
        f32x4 gs[4], sh[4];
#pragma unroll
        for (int q = 0; q < 4; ++q) { const int c = (q >> 1) * 512 + lane * 8 + (q & 1) * 4;
            const f32x4 gg = *(const f32x4*)(g + c), sc = *(const f32x4*)(mb + scoff + c); sh[q] = *(const f32x4*)(mb + shoff + c);
            gs[q] = gg * (sc + 1.0f); }
#pragma unroll 2
        for (int tk = 0; tk < 16; ++tk) { const int tok = t0 + tk;
            f32x4 v[4];
            if (SRC_BF16) { const bf16_t* xr = (const bf16_t*)srcv + (size_t)tok * DM; const u32x4 a = *(const u32x4*)(xr + lane * 8), b = *(const u32x4*)(xr + 512 + lane * 8);
                v[0] = (f32x4){blo(a.x), bhi(a.x), blo(a.y), bhi(a.y)}; v[1] = (f32x4){blo(a.z), bhi(a.z), blo(a.w), bhi(a.w)}; v[2] = (f32x4){blo(b.x), bhi(b.x), blo(b.y), bhi(b.y)}; v[3] = (f32x4){blo(b.z), bhi(b.z), blo(b.w), bhi(b.w)};
            } else { const float* xr = (const float*)srcv + (size_t)tok * DM;
                v[0] = *(const f32x4*)(xr + lane * 8); v[1] = *(const f32x4*)(xr + lane * 8 + 4); v[2] = *(const f32x4*)(xr + 512 + lane * 8); v[3] = *(const f32x4*)(xr + 512 + lane * 8 + 4); }
            float ss = 0.f;
#pragma unroll
            for (int q = 0; q < 4; ++q) ss += v[q][0] * v[q][0] + v[q][1] * v[q][1] + v[q][2] * v[q][2] + v[q][3] * v[q][3];
            ss = wave_sum(ss); const float rstd = rsqrtf(ss * (1.0f / 1024.0f) + 1e-6f);
            f32x4 y[4];
#pragma unroll
            for (int q = 0; q < 4; ++q) y[q] = (v[q] * rstd) * gs[q] + sh[q];
            u32x4 w0, w1; w0.x = pack2(y[0][0], y[0][1]); w0.y = pack2(y[0][2], y[0][3]); w0.z = pack2(y[1][0], y[1][1]); w0.w = pack2(y[1][2], y[1][3]);
            w1.x = pack2(y[2][0], y[2][1]); w1.y = pack2(y[2][2], y[2][3]); w1.z = pack2(y[3][0], y[3][1]); w1.w = pack2(y[3][2], y[3][3]);
            *(u32x4*)(dst + (size_t)tok * DM + lane * 8) = w0; *(u32x4*)(dst + (size_t)tok * DM + 512 + lane * 8) = w1; }
    }
}
constexpr int DNU_LDS = 35840;
DI void dn_prep(const Params& p, LAS unsigned char* L, int bid, int nb) {
    const int tid = threadIdx.x, sub = tid >> 7;
    unsigned char* ws = p.ws;
    const bf16_t* P = (const bf16_t*)(ws + OFF_P);
    bf16_t* QF = (bf16_t*)((unsigned char*)p.out + OUT_QF); bf16_t* KF = (bf16_t*)((unsigned char*)p.out + OUT_KF);
    bf16_t* WF = (bf16_t*)(ws + OFF_WF); bf16_t* UF = (bf16_t*)(ws + OFF_UF); bf16_t* AF = (bf16_t*)(ws + OFF_AF); float* GL = (float*)(ws + OFF_GL);
    const float* conv_w = p.in[13];
    LAS unsigned char* UB = L + sub * DNU_LDS;
    LAS bf16_t* qn = (LAS bf16_t*)UB; LAS bf16_t* kn = (LAS bf16_t*)(UB + 9216); LAS float* Am = (LAS float*)(UB + 18432);
    LAS float* sbeta = (LAS float*)(UB + 34816); LAS float* sgc = sbeta + 64; LAS float* sg = sbeta + 128;
    LAS float* cwl = (LAS float*)(L + 4 * DNU_LDS);
    int hcur = -1;
    for (int ub = bid; ub < 1024; ub += nb) {
        int tau = tid & 127; asm volatile("" : "+v"(tau));
        const int lane = tau & 63, wu = tau >> 6, l31 = lane & 31, hh = lane >> 5;
        const int un = ub * 4 + sub, c = un & 63, h = (un >> 6) & 7, b = un >> 9;
        { const int h0 = ((ub * 4) >> 6) & 7;
          if (h0 != hcur) { __syncthreads(); for (int q = tid; q < 768; q += 512) { const int i = q / 192, rr = q % 192; cwl[q] = conv_w[i * 1536 + (rr >> 6) * 512 + h0 * 64 + (rr & 63)]; } hcur = h0; __syncthreads(); } }
        const size_t tok0 = (size_t)b * SEQ + c * 64, uoff = (size_t)un * 4096;
        u32x4 rawr[2][5];
#pragma unroll
        for (int part = 0; part < 2; ++part)
#pragma unroll
            for (int q5 = 0; q5 < 5; ++q5) { const int pc = tau + 128 * q5, r = pc >> 3, ch = pc & 7; rawr[part][q5] = (u32x4){0u, 0u, 0u, 0u};
                if (pc < 67 * 8 && c * 64 + r - 3 >= 0) rawr[part][q5] = *(const u32x4*)(P + (tok0 + r - 3) * NP + (part ? CDK : CDQ) + h * 64 + ch * 8); }
        if (tau < 64) { const size_t tok = tok0 + tau; const float a = bf2f(P[tok * NP + CA + h]), bl = bf2f(P[tok * NP + CB + h]);
            const float x = a + p.in[15][h]; const float sp = x > 20.f ? x : log1pf(__expf(x));
            sg[tau] = -__expf(p.in[14][h]) * sp; sbeta[tau] = sigmf(bl); }
        __syncthreads();
        if (tau < 64) { int tq = tau; asm volatile("" : "+v"(tq));
            float s = 0.f; for (int j = 0; j < 64; ++j) { const float gj = sg[j]; s += (j <= tq) ? gj : 0.f; } sgc[tau] = s; }
        __syncthreads();
#pragma unroll
        for (int rp2 = 0; rp2 < 1 + ((MK_REP >> 21) & 1); ++rp2)
        { const int t = tau >> 1, hf = tau & 1; const float gct = sgc[t]; const float eq = __expf(gct), ek = __expf(sgc[63] - gct);
          LAS bf16_t* raw = (LAS bf16_t*)Am;
#pragma unroll
          for (int part = 0; part < 2; ++part) {
            __syncthreads();
#pragma unroll
            for (int q5 = 0; q5 < 5; ++q5) { const int pc = tau + 128 * q5, r = pc >> 3, ch = pc & 7; if (pc < 67 * 8) *(LAS u32x4*)(raw + r * 72 + ch * 8) = rawr[part][q5]; }
            __syncthreads();
            float y[32];
#pragma unroll
            for (int v = 0; v < 4; ++v) { float a8[8];
#pragma unroll
                for (int j = 0; j < 8; ++j) a8[j] = 0.f;
#pragma unroll
                for (int i = 0; i < 4; ++i) {
                    const u32x4 rw = *(const LAS u32x4*)(raw + (t + i) * 72 + hf * 32 + v * 8);
                    const LAS float* cw = cwl + (i * 3 + part) * 64 + hf * 32 + v * 8; const f32x4 w0 = *(const LAS f32x4*)cw, w1 = *(const LAS f32x4*)(cw + 4);
                    a8[0] += w0[0] * blo(rw.x); a8[1] += w0[1] * bhi(rw.x); a8[2] += w0[2] * blo(rw.y); a8[3] += w0[3] * bhi(rw.y);
                    a8[4] += w1[0] * blo(rw.z); a8[5] += w1[1] * bhi(rw.z); a8[6] += w1[2] * blo(rw.w); a8[7] += w1[3] * bhi(rw.w); }
#pragma unroll
                for (int j = 0; j < 8; ++j) y[v * 8 + j] = siluf(a8[j]); }
            float ss = 0.f;
#pragma unroll
            for (int d = 0; d < 32; ++d) ss += y[d] * y[d];
            ss += __shfl_xor(ss, 1);
            const float rn = rsqrtf(ss + 1e-6f) * (part == 0 ? 0.125f : 1.0f);
#pragma unroll
            for (int d = 0; d < 32; ++d) y[d] *= rn;
            LAS bf16_t* tile = part ? kn : qn;
#pragma unroll
            for (int v = 0; v < 4; ++v) { u32x4 w; w.x = pack2(y[v * 8], y[v * 8 + 1]); w.y = pack2(y[v * 8 + 2], y[v * 8 + 3]); w.z = pack2(y[v * 8 + 4], y[v * 8 + 5]); w.w = pack2(y[v * 8 + 6], y[v * 8 + 7]);
                *(LAS u32x4*)(tile + t * 72 + hf * 32 + v * 8) = w; }
            if (part == 0) {
#pragma unroll
                for (int s2 = 0; s2 < 2; ++s2)
#pragma unroll
                    for (int hp = 0; hp < 2; ++hp) { const int o = 16 * s2 + 4 * hp; u32x4 w;
                        w.x = pack2(y[o] * eq, y[o + 1] * eq); w.y = pack2(y[o + 2] * eq, y[o + 3] * eq); w.z = pack2(y[o + 8] * eq, y[o + 9] * eq); w.w = pack2(y[o + 10] * eq, y[o + 11] * eq);
                        *(u32x4*)(QF + uoff + (size_t)((((t >> 5) * 4 + 2 * hf + s2) * 64 + (t & 31) + 32 * hp) * 8)) = w; }
            }
          }
          sg[t] = ek; }
        __syncthreads();
#pragma unroll
        for (int rp3 = 0; rp3 < 1 + ((MK_REP >> 22) & 1); ++rp3)
#pragma unroll
        for (int q = 0; q < 4; ++q) { const int pid = tau + 128 * q, rt = pid >> 8, s = (pid >> 6) & 3, lp = pid & 63, kap = 32 * rt + (lp & 31), hp = lp >> 5; float e8[8];
#pragma unroll
            for (int e = 0; e < 8; ++e) { const int te = 16 * s + 8 * (e >> 2) + 4 * hp + (e & 3); e8[e] = bf2f(kn[te * 72 + kap]) * sg[te]; }
            u32x4 w; w.x = pack2(e8[0], e8[1]); w.y = pack2(e8[2], e8[3]); w.z = pack2(e8[4], e8[5]); w.w = pack2(e8[6], e8[7]);
            *(u32x4*)(KF + uoff + (size_t)pid * 8) = w; }
#pragma unroll
        for (int rp4 = 0; rp4 < 1 + ((MK_REP >> 23) & 1); ++rp4)
        { bf16x8 kf[2][4], qf[4];
#pragma unroll
          for (int rt = 0; rt < 2; ++rt)
#pragma unroll
            for (int s = 0; s < 4; ++s) kf[rt][s] = *(const LAS bf16x8*)(kn + (32 * rt + l31) * 72 + 16 * s + 8 * hh);
#pragma unroll
          for (int s = 0; s < 4; ++s) qf[s] = *(const LAS bf16x8*)(qn + (32 * wu + l31) * 72 + 16 * s + 8 * hh);
          f32x16 dk[2], da[2]; dk[0] = zero16(); dk[1] = zero16(); da[0] = zero16(); da[1] = zero16();
#pragma unroll
          for (int s = 0; s < 4; ++s) { const bf16x8 kb = wu ? kf[1][s] : kf[0][s];
              dk[0] = MFMA32(kf[0][s], kb, dk[0]); dk[1] = MFMA32(kf[1][s], kb, dk[1]);
              da[0] = MFMA32(kf[0][s], qf[s], da[0]); da[1] = MFMA32(kf[1][s], qf[s], da[1]); }
          int jc = 32 * wu + l31; asm volatile("" : "+v"(jc)); const float gcj = sgc[jc];
#pragma unroll
          for (int it = 0; it < 2; ++it)
#pragma unroll
            for (int r = 0; r < 16; ++r) { const int i = 32 * it + crow(r, hh); float v = 0.f;
                if (i > jc) v = sbeta[i] * dk[it][r] * __expf(sgc[i] - gcj);
                Am[i * 64 + jc] = v; }
#pragma unroll
          for (int jt = 0; jt < 2; ++jt)
#pragma unroll
            for (int s2 = 0; s2 < 2; ++s2) { float e8[8];
#pragma unroll
                for (int e = 0; e < 8; ++e) { const int r = 8 * s2 + e, j = 32 * jt + crow(r, hh); e8[e] = (jc >= j) ? da[jt][r] * __expf(gcj - sgc[j]) : 0.f; }
                u32x4 w; w.x = pack2(e8[0], e8[1]); w.y = pack2(e8[2], e8[3]); w.z = pack2(e8[4], e8[5]); w.w = pack2(e8[6], e8[7]);
                *(u32x4*)(AF + uoff + (size_t)(((wu * 4 + 2 * jt + s2) * 64 + lane) * 8)) = w; }
        }
        __syncthreads();
#pragma unroll
        for (int rp5 = 0; rp5 < 1 + ((MK_REP >> 24) & 1); ++rp5)
        { float x[64];
          if (tau < 64) { const int colv = CDV + h * 64 + tau;
              const float w0 = cwl[128 + tau], w1 = cwl[192 + 128 + tau], w2 = cwl[384 + 128 + tau], w3 = cwl[576 + 128 + tau];
              float x0 = 0.f, x1 = 0.f, x2 = 0.f;
              if (c > 0) { x0 = bf2f(P[(tok0 - 3) * NP + colv]); x1 = bf2f(P[(tok0 - 2) * NP + colv]); x2 = bf2f(P[(tok0 - 1) * NP + colv]); }
              const bf16_t* pv = P + tok0 * NP + colv;
#pragma unroll
              for (int i = 0; i < 64; ++i) { const float x3 = bf2f(*pv); pv += NP; asm volatile("" : "+v"(pv));
                  const float yv = w0 * x0 + w1 * x1 + w2 * x2 + w3 * x3;
                  x[i] = siluf(yv) * sbeta[i]; x0 = x1; x1 = x2; x2 = x3; }
          } else { const int kk = tau - 64;
#pragma unroll
              for (int i = 0; i < 64; ++i) x[i] = bf2f(kn[i * 72 + kk]) * sbeta[i] * __expf(sgc[i]); }
          f32x4 an[16];
          an[0] = *(const LAS f32x4*)(Am + 64);
#pragma unroll
          for (int i = 1; i < 64; ++i) { f32x4 ac[16];
#pragma unroll
              for (int j4 = 0; j4 < (i + 3) / 4; ++j4) ac[j4] = an[j4];
              if (i + 1 < 64) {
#pragma unroll
                  for (int j4 = 0; j4 < (i + 4) / 4; ++j4) an[j4] = *(const LAS f32x4*)(Am + (i + 1) * 64 + 4 * j4); }
              __builtin_amdgcn_sched_barrier(0);
              float s0 = x[i], s1 = 0.f, s2 = 0.f, s3 = 0.f;
#pragma unroll
              for (int j4 = 0; j4 < (i + 3) / 4; ++j4) { const f32x4 a = ac[j4];
                  s0 -= a[0] * x[4 * j4]; s1 -= a[1] * x[4 * j4 + 1]; s2 -= a[2] * x[4 * j4 + 2]; s3 -= a[3] * x[4 * j4 + 3]; }
              x[i] = (s0 + s1) + (s2 + s3); }
          if (tau < 64) { const int slice = tau >> 5;
#pragma unroll
              for (int rt = 0; rt < 2; ++rt)
#pragma unroll
                for (int hp = 0; hp < 2; ++hp) { u32x4 wa, wb; const int o = 32 * rt + 4 * hp;
                    wa.x = pack2(x[o], x[o + 1]); wa.y = pack2(x[o + 2], x[o + 3]); wa.z = pack2(x[o + 8], x[o + 9]); wa.w = pack2(x[o + 10], x[o + 11]);
                    wb.x = pack2(x[o + 16], x[o + 17]); wb.y = pack2(x[o + 18], x[o + 19]); wb.z = pack2(x[o + 24], x[o + 25]); wb.w = pack2(x[o + 26], x[o + 27]);
                    bf16_t* dp = UF + uoff + (size_t)((((slice * 2 + rt) * 64) + (tau & 31) + 32 * hp) * 16);
                    *(u32x4*)dp = wa; *(u32x4*)(dp + 8) = wb; }
          } else { const int kk = tau - 64;
#pragma unroll
              for (int i = 0; i < 64; ++i) qn[i * 72 + kk] = f2bf(x[i]); }
        }
        __syncthreads();
#pragma unroll
        for (int q = 0; q < 4; ++q) { const int pid = tau + 128 * q, rt = pid >> 8, s = (pid >> 6) & 3, lp = pid & 63, row = 32 * rt + (lp & 31), hp = lp >> 5;
            const u32x2 lo = *(const LAS u32x2*)(qn + row * 72 + 16 * s + 4 * hp), hi = *(const LAS u32x2*)(qn + row * 72 + 16 * s + 8 + 4 * hp);
            u32x4 w; w.x = lo.x; w.y = lo.y; w.z = hi.x; w.w = hi.y;
            *(u32x4*)(WF + uoff + (size_t)pid * 8) = w; }
        if (tau == 0) GL[un] = __expf(sgc[63]);
        __syncthreads();
    }
}
constexpr int DNS_LDS = 57600;
template <int NB>
DI void dn_scan(const Params& p, LAS unsigned char* L, int bh0) {
    const int tid = threadIdx.x, wave = tid >> 6, lane = tid & 63, l31 = lane & 31, hh = lane >> 5;
    unsigned char* ws = p.ws;
    const bf16_t* P = (const bf16_t*)(ws + OFF_P);
    const bf16_t* src[5] = { (const bf16_t*)(ws + OFF_WF), (const bf16_t*)((unsigned char*)p.out + OUT_KF), (const bf16_t*)((unsigned char*)p.out + OUT_QF), (const bf16_t*)(ws + OFF_AF), (const bf16_t*)(ws + OFF_UF) };
    const float* GL = (const float*)(ws + OFF_GL);
    bf16_t* ODN = (bf16_t*)((unsigned char*)p.out + OUT_ODN);
    u32x4 pre[NB][5];
#pragma unroll
    for (int j = 0; j < NB; ++j) { const size_t un = (size_t)(bh0 + j) * 64;
#pragma unroll
      for (int k = 0; k < 5; ++k) pre[j][k] = *(const u32x4*)(src[k] + un * 4096 + tid * 8);
#pragma unroll
      for (int k = 0; k < 5; ++k) *(LAS u32x4*)(L + j * DNS_LDS + k * 8192 + tid * 16) = pre[j][k]; }
    __syncthreads();
    f32x16 S[2]; S[0] = zero16(); S[1] = zero16();
    for (int c = 0; c < 64; ++c) {
        u32x4 zr[NB];
#pragma unroll
        for (int j = 0; j < NB; ++j) { const int bh = bh0 + j, b = bh >> 3, h = bh & 7; const size_t un = (size_t)bh * 64 + c;
            if (c < 63) {
#pragma unroll
                for (int k = 0; k < 5; ++k) pre[j][k] = *(const u32x4*)(src[k] + (un + 1) * 4096 + tid * 8); }
            zr[j] = *(const u32x4*)(P + ((size_t)b * SEQ + c * 64 + (tid >> 3)) * NP + CZ + h * 64 + (tid & 7) * 8); }
        if (wave < 2 * NB) {
            const int sl = wave & 1, js = wave >> 1;
            LAS unsigned char* B = L + js * DNS_LDS; LAS float* ot = (LAS float*)(B + 40960);
            LAS unsigned char* Wt = B; LAS unsigned char* Kt = B + 8192; LAS unsigned char* Qt = B + 16384; LAS unsigned char* At = B + 24576; LAS unsigned char* Ut = B + 32768;
            bf16x8 Sb[4]; Sb[0] = pack8(S[0], 0); Sb[1] = pack8(S[0], 1); Sb[2] = pack8(S[1], 0); Sb[3] = pack8(S[1], 1);
            f32x16 T1[2]; T1[0] = zero16(); T1[1] = zero16();
#pragma unroll
            for (int rt = 0; rt < 2; ++rt)
#pragma unroll
                for (int sp = 0; sp < 4; ++sp) T1[rt] = MFMA32(*(const LAS bf16x8*)(Wt + ((rt * 4 + sp) * 64 + lane) * 16), Sb[sp], T1[rt]);
            f32x16 vn[2];
#pragma unroll
            for (int rt = 0; rt < 2; ++rt) { const u32x4 ua = *(const LAS u32x4*)(Ut + ((sl * 2 + rt) * 64 + lane) * 32), ub = *(const LAS u32x4*)(Ut + ((sl * 2 + rt) * 64 + lane) * 32 + 16);
                vn[rt][0] = blo(ua.x) - T1[rt][0]; vn[rt][1] = bhi(ua.x) - T1[rt][1]; vn[rt][2] = blo(ua.y) - T1[rt][2]; vn[rt][3] = bhi(ua.y) - T1[rt][3];
                vn[rt][4] = blo(ua.z) - T1[rt][4]; vn[rt][5] = bhi(ua.z) - T1[rt][5]; vn[rt][6] = blo(ua.w) - T1[rt][6]; vn[rt][7] = bhi(ua.w) - T1[rt][7];
                vn[rt][8] = blo(ub.x) - T1[rt][8]; vn[rt][9] = bhi(ub.x) - T1[rt][9]; vn[rt][10] = blo(ub.y) - T1[rt][10]; vn[rt][11] = bhi(ub.y) - T1[rt][11];
                vn[rt][12] = blo(ub.z) - T1[rt][12]; vn[rt][13] = bhi(ub.z) - T1[rt][13]; vn[rt][14] = blo(ub.w) - T1[rt][14]; vn[rt][15] = bhi(ub.w) - T1[rt][15]; }
            bf16x8 Vb[4]; Vb[0] = pack8(vn[0], 0); Vb[1] = pack8(vn[0], 1); Vb[2] = pack8(vn[1], 0); Vb[3] = pack8(vn[1], 1);
            f32x16 O[2]; O[0] = zero16(); O[1] = zero16();
#pragma unroll
            for (int rt = 0; rt < 2; ++rt)
#pragma unroll
                for (int sp = 0; sp < 4; ++sp) { O[rt] = MFMA32(*(const LAS bf16x8*)(Qt + ((rt * 4 + sp) * 64 + lane) * 16), Sb[sp], O[rt]);
                                                 O[rt] = MFMA32(*(const LAS bf16x8*)(At + ((rt * 4 + sp) * 64 + lane) * 16), Vb[sp], O[rt]); }
            const float gl = GL[(size_t)(bh0 + js) * 64 + c];
#pragma unroll
            for (int rt = 0; rt < 2; ++rt) {
#pragma unroll
                for (int r = 0; r < 16; ++r) S[rt][r] *= gl;
#pragma unroll
                for (int sp = 0; sp < 4; ++sp) S[rt] = MFMA32(*(const LAS bf16x8*)(Kt + ((rt * 4 + sp) * 64 + lane) * 16), Vb[sp], S[rt]); }
#pragma unroll
            for (int rt = 0; rt < 2; ++rt)
#pragma unroll
                for (int r = 0; r < 16; ++r) ot[(32 * rt + crow(r, hh)) * 65 + 32 * sl + l31] = O[rt][r];
        }
        __syncthreads();
#pragma unroll
        for (int j = 0; j < NB; ++j) { const int bh = bh0 + j, b = bh >> 3, h = bh & 7;
            if (c < 63) {
#pragma unroll
                for (int k = 0; k < 5; ++k) *(LAS u32x4*)(L + j * DNS_LDS + k * 8192 + tid * 16) = pre[j][k]; }
            LAS float* ot = (LAS float*)(L + j * DNS_LDS + 40960);
            const int t = tid >> 3, part = tid & 7; float o8[8]; float ss = 0.f;
#pragma unroll
            for (int q = 0; q < 8; ++q) { o8[q] = ot[t * 65 + part * 8 + q]; ss += o8[q] * o8[q]; }
            ss += __shfl_xor(ss, 1); ss += __shfl_xor(ss, 2); ss += __shfl_xor(ss, 4);
            const float rstd = rsqrtf(ss * (1.0f / 64.0f) + 1e-6f);
            const size_t tok = (size_t)b * SEQ + c * 64 + t;
            const float* ng = p.in[16] + part * 8;
            const u32x4 z = zr[j];
            float z8[8]; z8[0] = blo(z.x); z8[1] = bhi(z.x); z8[2] = blo(z.y); z8[3] = bhi(z.y); z8[4] = blo(z.z); z8[5] = bhi(z.z); z8[6] = blo(z.w); z8[7] = bhi(z.w);
            float y8[8];
#pragma unroll
            for (int q = 0; q < 8; ++q) y8[q] = o8[q] * rstd * ng[q] * siluf(z8[q]);
            u32x4 w; w.x = pack2(y8[0], y8[1]); w.y = pack2(y8[2], y8[3]); w.z = pack2(y8[4], y8[5]); w.w = pack2(y8[6], y8[7]);
            *(u32x4*)(ODN + tok * 512 + h * 64 + part * 8) = w; }
        __syncthreads();
    }
}
DI void compress_task(const Params& p, LAS unsigned char* L, int task) {
    const int tid = threadIdx.x, w = tid >> 6, lane = tid & 63, l31 = lane & 31, hh = lane >> 5;
    unsigned char* ws = p.ws;
    const int which = task >> 7, rem = task & 127, b = rem >> 4, kvh = (rem >> 3) & 1, nt = rem & 7;
    const bf16_t* P = (const bf16_t*)(ws + OFF_P);
    const bf16_t* W1T = (const bf16_t*)(ws + (which ? OFF_W1V : OFF_W1K)); const bf16_t* W2T = (const bf16_t*)(ws + (which ? OFF_W2V : OFF_W2K));
    const int col = (which ? CVC : CKC) + kvh * 64, n = nt * 32 + l31, nc = n < 254 ? n : 254;
    f32x16 acc[2]; acc[0] = zero16(); acc[1] = zero16();
#pragma unroll 4
    for (int ksl = 0; ksl < 16; ++ksl) { const int ks = 16 * w + ksl, ltok = ks >> 2, d0 = (ks & 3) * 16 + 8 * hh;
        const bf16x8 bfr = *(const bf16x8*)(P + ((size_t)b * SEQ + 16 * nc + ltok) * NP + col + d0);
#pragma unroll
        for (int rt = 0; rt < 2; ++rt) { const bf16x8 a = *(const bf16x8*)(W1T + (size_t)(32 * rt + l31) * 2048 + 16 * ks + 8 * hh); acc[rt] = MFMA32(a, bfr, acc[rt]); } }
    LAS float* red = (LAS float*)L;
#pragma unroll
    for (int rt = 0; rt < 2; ++rt)
#pragma unroll
        for (int r = 0; r < 16; ++r) red[((w * 2 + rt) * 16 + r) * 64 + lane] = acc[rt][r];
    __syncthreads();
    if (w == 0) {
        const float* c1 = (const float*)(ws + OFF_C1) + which * 64;
        f32x16 G[2];
#pragma unroll
        for (int rt = 0; rt < 2; ++rt)
#pragma unroll
            for (int r = 0; r < 16; ++r) { float s = c1[32 * rt + crow(r, hh)];
#pragma unroll
                for (int w2 = 0; w2 < 8; ++w2) s += red[((w2 * 2 + rt) * 16 + r) * 64 + lane];
                G[rt][r] = gelu_tanh(s); }
        bf16x8 Hb[4]; Hb[0] = pack8(G[0], 0); Hb[1] = pack8(G[0], 1); Hb[2] = pack8(G[1], 0); Hb[3] = pack8(G[1], 1);
        bf16_t* KC = (bf16_t*)(ws + OFF_KC); bf16_t* VCT = (bf16_t*)(ws + OFF_VCT);
#pragma unroll
        for (int ot = 0; ot < 2; ++ot) { f32x16 o = zero16(); const int row = 32 * ot + l31;
#pragma unroll
            for (int sp = 0; sp < 4; ++sp) { const u32x2 lo = *(const u32x2*)(W2T + row * 64 + 16 * sp + 4 * hh), hi = *(const u32x2*)(W2T + row * 64 + 16 * sp + 8 + 4 * hh);
                u32x4 aw; aw.x = lo.x; aw.y = lo.y; aw.z = hi.x; aw.w = hi.y; o = MFMA32(__builtin_bit_cast(bf16x8, aw), Hb[sp], o); }
            if (which == 0) {
#pragma unroll
                for (int a = 0; a < 4; ++a) { u32x2 wv; wv.x = pack2(o[4 * a], o[4 * a + 1]); wv.y = pack2(o[4 * a + 2], o[4 * a + 3]);
                    *(u32x2*)(KC + ((size_t)((b * 2 + kvh) * 256 + n)) * 64 + 32 * ot + 8 * a + 4 * hh) = wv; }
            } else {
#pragma unroll
                for (int r = 0; r < 16; ++r) VCT[((size_t)((b * 2 + kvh) * 64 + 32 * ot + crow(r, hh))) * 256 + (n & ~15) + vperm16(n & 15)] = f2bf(o[r]);
            }
        }
    }
    __syncthreads();
}
DI void vtrans_unit(const Params& p, LAS unsigned char* L, int unit0) {
    const int tid = threadIdx.x;
    unsigned char* ws = p.ws;
    const bf16_t* P = (const bf16_t*)(ws + OFF_P);
    { const int tok = tid >> 3, ch = tid & 7; u32x4 v[4];
#pragma unroll
      for (int q = 0; q < 4; ++q) { const int unit = unit0 + q, which = unit >> 10, rem = unit & 1023, b = rem >> 7, kvh = (rem >> 6) & 1, blk = rem & 63;
          v[q] = *(const u32x4*)(P + ((size_t)b * SEQ + blk * 64 + tok) * NP + (which ? CVW : CVS) + kvh * 64 + ch * 8); }
#pragma unroll
      for (int q = 0; q < 4; ++q) *(LAS u32x4*)((LAS bf16_t*)(L + q * 9216) + tok * 72 + ch * 8) = v[q]; }
    __syncthreads();
    { const int d = tid >> 3, ch = tid & 7, grp = ch >> 1, hq = ch & 1;
#pragma unroll
      for (int q = 0; q < 4; ++q) { const int unit = unit0 + q, which = unit >> 10, rem = unit & 1023, b = rem >> 7, kvh = (rem >> 6) & 1, blk = rem & 63;
          LAS bf16_t* tile = (LAS bf16_t*)(L + q * 9216); bf16_t e8[8];
#pragma unroll
          for (int e = 0; e < 8; ++e) e8[e] = tile[(16 * grp + 8 * (e >> 2) + 4 * hq + (e & 3)) * 72 + d];
          u32x4 w; w.x = (unsigned)e8[0] | ((unsigned)e8[1] << 16); w.y = (unsigned)e8[2] | ((unsigned)e8[3] << 16); w.z = (unsigned)e8[4] | ((unsigned)e8[5] << 16); w.w = (unsigned)e8[6] | ((unsigned)e8[7] << 16);
          bf16_t* VT = (bf16_t*)(ws + (which ? OFF_VTW : OFF_VTS));
          *(u32x4*)(VT + ((size_t)((b * 2 + kvh) * 64 + d)) * SEQ + blk * 64 + ch * 8) = w; } }
    __syncthreads();
}
constexpr int AT_K = 0, AT_V = 18432, AT_IMP = 36864, AT_BT = 53504, AT_SEL = 55552, AT_TL = 56064, AT_OACC = 63488, AT_Q = 96256;
struct AttnCtx { int i, g, th, l31, hh, lane, tid, tq; };
DI float xhalf_max(float v) {
    const auto r = __builtin_amdgcn_permlane32_swap(__float_as_uint(v), __float_as_uint(v), false, false); return fmaxf(__uint_as_float(r[0]), __uint_as_float(r[1])); }
template <int BR, int MODE>
DI void attn_tiles(LAS unsigned char* L, const AttnCtx& cx, const bf16_t* Kbase, size_t kpitch, const bf16_t* VTbase, size_t vpitch, int ntiles, int id0,
                   const LAS unsigned char* Ql, float& m, float& l, f32x16 (&O)[2]) {
    if (ntiles <= 0) return;
    const int tid = cx.tid, l31 = cx.l31, hh = cx.hh;
    LAS int* tl = (LAS int*)(L + AT_TL); LAS float* bt = (LAS float*)(L + AT_BT) + cx.g * 128; LAS float* imp = (LAS float*)(L + AT_IMP); LAS unsigned* selm = (LAS unsigned*)(L + AT_SEL);
    int srow = tid >> 3; const int sch = tid & 7; asm volatile("" : "+v"(srow));
    constexpr float QS = 0.125f * 1.4426950408889634f;
    u32x4 kreg, vreg;
    { const int id = (BR == 1) ? tl[1] : id0;
      kreg = *(const u32x4*)(Kbase + (size_t)(id * 64 + srow) * kpitch + sch * 8);
      if (MODE == 0) vreg = *(const u32x4*)(VTbase + (size_t)srow * vpitch + id * 64 + sch * 8);
      *(LAS u32x4*)(L + AT_K + srow * 144 + sch * 16) = kreg;
      if (MODE == 0) *(LAS u32x4*)(L + AT_V + srow * 144 + sch * 16) = vreg; }
    __syncthreads();
    const float inv = (MODE == 1) ? (l > 0.f ? 1.0f / l : 0.f) : 0.f;
    const float bconst = bt[127];
    for (int k = 0; k < ntiles; ++k) {
        const int buf = k & 1;
        const int id = (BR == 1) ? tl[1 + k] : id0 + k;
        LAS unsigned char* Kt = L + AT_K + buf * 9216; LAS unsigned char* Vt = L + AT_V + buf * 9216;
        const int lastpos = (BR == 0) ? (16 * (id * 64 + 63) + 31) : (id * 64 + 63);
        const bool cbias = (64 * cx.i - lastpos) >= 127;
        const bool edge = (MODE == 1) ? true : (BR == 0) ? (lastpos > 64 * cx.i) : (BR == 1) ? (id == cx.i) : (id == cx.i || id == cx.i - 8);
        bool sel = true;
        if (BR == 1) sel = ((selm[(32 * cx.th + l31) * 2 + (id >> 5)] >> (id & 31)) & 1u) != 0u;
        f32x16 S0 = zero16(), S1 = zero16();
#pragma unroll
        for (int s = 0; s < 4; ++s) { const bf16x8 qf = *(const LAS bf16x8*)(Ql + 32 * s);
                                      S0 = MFMA32(*(const LAS bf16x8*)(Kt + l31 * 144 + (16 * s + 8 * hh) * 2), qf, S0);
                                      S1 = MFMA32(*(const LAS bf16x8*)(Kt + (32 + l31) * 144 + (16 * s + 8 * hh) * 2), qf, S1); }
#if (MK_REP >> 27) & 1
        { f32x16 T0 = zero16(), T1 = zero16();
#pragma unroll
          for (int s = 0; s < 4; ++s) { bf16x8 qf = *(const LAS bf16x8*)(Ql + 32 * s); asm volatile("" : "+v"(qf));
              T0 = MFMA32(*(const LAS bf16x8*)(Kt + l31 * 144 + (16 * s + 8 * hh) * 2), qf, T0); T1 = MFMA32(*(const LAS bf16x8*)(Kt + (32 + l31) * 144 + (16 * s + 8 * hh) * 2), qf, T1); }
          asm volatile("" :: "v"(T0[0] + T0[7] + T1[3] + T1[15])); }
#endif
        asm volatile("" ::: "memory");
        if (k + 1 < ntiles) { const int idn = (BR == 1) ? tl[2 + k] : id0 + k + 1;
            kreg = *(const u32x4*)(Kbase + (size_t)(idn * 64 + srow) * kpitch + sch * 8);
            if (MODE == 0) vreg = *(const u32x4*)(VTbase + (size_t)srow * vpitch + idn * 64 + sch * 8); }
        const int kb0 = id * 64 + 4 * hh;
        if (MODE == 0 && cbias && !edge) {
            float mx = fmaxf(S0[0], S1[0]);
#pragma unroll
            for (int r = 1; r < 16; ++r) mx = fmaxf(fmaxf(mx, S0[r]), S1[r]);
            mx = mx * QS + bconst;
            if (BR == 1) mx = sel ? mx : -1e30f;
            mx = xhalf_max(mx);
            const float mn = fmaxf(m, mx);
            { const float alpha = __builtin_amdgcn_exp2f(m - mn); l *= alpha;
#pragma unroll
                for (int r = 0; r < 16; ++r) { O[0][r] *= alpha; O[1][r] *= alpha; } }
            m = mn;
            const float c0 = bconst - (((mn <= -1e29f) || !sel) ? 3.0e38f : mn);
            float rs = 0.f;
#pragma unroll
            for (int r = 0; r < 16; ++r) { S0[r] = __builtin_amdgcn_exp2f(__builtin_fmaf(S0[r], QS, c0)); S1[r] = __builtin_amdgcn_exp2f(__builtin_fmaf(S1[r], QS, c0)); rs += S0[r] + S1[r]; }
            l += rs;
#if (MK_REP >> 28) & 1
            { float dd = 0.f;
#pragma unroll
              for (int r = 0; r < 16; ++r) { float a = S0[r], b = S1[r]; asm volatile("" : "+v"(a), "+v"(b)); dd += __builtin_amdgcn_exp2f(__builtin_fmaf(a, QS, c0)) + __builtin_amdgcn_exp2f(__builtin_fmaf(b, QS, c0)); }
              asm volatile("" :: "v"(dd)); }
#endif
        } else {
        if (cbias) {
#pragma unroll
            for (int r = 0; r < 16; ++r) { S0[r] = __builtin_fmaf(S0[r], QS, bconst); S1[r] = __builtin_fmaf(S1[r], QS, bconst); }
        } else {
#pragma unroll
            for (int r = 0; r < 16; ++r) { const int k0i = kb0 + 8 * (r >> 2) + (r & 3), k1i = k0i + 32;
                int d0 = (BR == 0) ? (cx.tq - (16 * k0i + 31)) : (cx.tq - k0i), d1 = (BR == 0) ? (cx.tq - (16 * k1i + 31)) : (cx.tq - k1i);
                d0 = d0 < 0 ? 0 : (d0 > 127 ? 127 : d0); d1 = d1 < 0 ? 0 : (d1 > 127 ? 127 : d1);
                S0[r] = __builtin_fmaf(S0[r], QS, bt[d0]); S1[r] = __builtin_fmaf(S1[r], QS, bt[d1]); }
        }
        if (edge) {
#pragma unroll
            for (int r = 0; r < 16; ++r) { const int k0i = kb0 + 8 * (r >> 2) + (r & 3), k1i = k0i + 32;
                const int d0 = (BR == 0) ? (cx.tq - (16 * k0i + 31)) : (cx.tq - k0i), d1 = (BR == 0) ? (cx.tq - (16 * k1i + 31)) : (cx.tq - k1i);
                bool v0 = d0 >= 0, v1 = d1 >= 0; if (BR == 2) { v0 = v0 && (d0 < 512); v1 = v1 && (d1 < 512); }
                S0[r] = v0 ? S0[r] : -1e30f; S1[r] = v1 ? S1[r] : -1e30f; }
        }
        if (MODE == 0) {
            float mx = -1e30f;
#pragma unroll
            for (int r = 0; r < 16; ++r) mx = fmaxf(fmaxf(mx, S0[r]), S1[r]);
            if (BR == 1) mx = sel ? mx : -1e30f;
            mx = xhalf_max(mx);
            const float mn = fmaxf(m, mx);
            { const float alpha = __builtin_amdgcn_exp2f(m - mn); l *= alpha;
#pragma unroll
                for (int r = 0; r < 16; ++r) { O[0][r] *= alpha; O[1][r] *= alpha; } }
            m = mn;
            const float mref = ((mn <= -1e29f) || !sel) ? 3.0e38f : mn;
            float rs = 0.f;
#pragma unroll
            for (int r = 0; r < 16; ++r) { S0[r] = __builtin_amdgcn_exp2f(S0[r] - mref); S1[r] = __builtin_amdgcn_exp2f(S1[r] - mref); rs += S0[r] + S1[r]; }
            l += rs;
        } }
        if (MODE == 0) {
            asm volatile("" ::: "memory");
            const bf16x8 P00 = pack8(S0, 0), P01 = pack8(S0, 1), P10 = pack8(S1, 0), P11 = pack8(S1, 1);
#pragma unroll
            for (int dt = 0; dt < 2; ++dt) {
                O[dt] = MFMA32(*(const LAS bf16x8*)(Vt + (32 * dt + l31) * 144 + (8 * hh) * 2), P00, O[dt]);
                O[dt] = MFMA32(*(const LAS bf16x8*)(Vt + (32 * dt + l31) * 144 + (16 + 8 * hh) * 2), P01, O[dt]);
                O[dt] = MFMA32(*(const LAS bf16x8*)(Vt + (32 * dt + l31) * 144 + (32 + 8 * hh) * 2), P10, O[dt]);
                O[dt] = MFMA32(*(const LAS bf16x8*)(Vt + (32 * dt + l31) * 144 + (48 + 8 * hh) * 2), P11, O[dt]); }
        } else {
            const float mref = (m <= -1e29f) ? 3.0e38f : m;
#pragma unroll
            for (int kt = 0; kt < 2; ++kt)
#pragma unroll
                for (int a = 0; a < 4; ++a) { float s4 = 0.f, p3 = 0.f;
#pragma unroll
                    for (int b2 = 0; b2 < 4; ++b2) { const int r = 4 * a + b2; const float pv = __builtin_amdgcn_exp2f((kt ? S1[r] : S0[r]) - mref) * inv; s4 += pv; if (b2 == 3) p3 = pv; }
                    const int jblk = 16 * id + 8 * kt + 2 * a + hh;
                    LAS float* ip = imp + (32 * cx.th + l31) * 65 + jblk;
                    __hip_atomic_fetch_add(ip, s4, __ATOMIC_RELAXED, __HIP_MEMORY_SCOPE_WORKGROUP);
                    if (jblk + 1 < 64) __hip_atomic_fetch_add(ip + 1, p3, __ATOMIC_RELAXED, __HIP_MEMORY_SCOPE_WORKGROUP); }
        }
        if (k + 1 < ntiles) { *(LAS u32x4*)(L + AT_K + ((k + 1) & 1) * 9216 + srow * 144 + sch * 16) = kreg;
            if (MODE == 0) *(LAS u32x4*)(L + AT_V + ((k + 1) & 1) * 9216 + srow * 144 + sch * 16) = vreg; }
        __syncthreads();
    }
    if (MODE == 0) l += __shfl_xor(l, 32);
}
DI void attn_unit(const Params& p, LAS unsigned char* L, int unit) {
    AttnCtx cx; cx.tid = threadIdx.x; const int wave = cx.tid >> 6; cx.lane = cx.tid & 63; cx.l31 = cx.lane & 31; cx.hh = cx.lane >> 5; cx.g = wave >> 1; cx.th = wave & 1;
    unsigned char* ws = p.ws;
    const int i = 63 - (unit >> 4), bk = unit & 15, b = bk >> 1, kvh = bk & 1, hq = kvh * 4 + cx.g;
    cx.i = i; cx.tq = 64 * i + 32 * cx.th + cx.l31;
    const bf16_t* P = (const bf16_t*)(ws + OFF_P);
    const size_t tokq = (size_t)b * SEQ + cx.tq;
    LAS float* imp = (LAS float*)(L + AT_IMP); LAS unsigned* selm = (LAS unsigned*)(L + AT_SEL); LAS int* tl = (LAS int*)(L + AT_TL);
    LAS unsigned char* Qf = L + AT_Q + (wave * 32 + cx.l31) * 144 + 16 * cx.hh;
#pragma unroll
    for (int s = 0; s < 4; ++s) *(LAS bf16x8*)(Qf + 32 * s) = *(const bf16x8*)(P + tokq * NP + CQ + hq * 64 + 16 * s + 8 * cx.hh);
    LAS float* gts = (LAS float*)(L + AT_TL + 320) + (wave * 64 + cx.lane) * 3;
    if (cx.hh == 0 || true) { gts[0] = sigmf(bf2f(P[tokq * NP + CNG + hq * 3 + 0])); gts[1] = sigmf(bf2f(P[tokq * NP + CNG + hq * 3 + 1])); gts[2] = sigmf(bf2f(P[tokq * NP + CNG + hq * 3 + 2])); }
    ((LAS float*)(L + AT_BT))[cx.tid] = ((const float*)(ws + OFF_BTAB))[kvh * 512 + cx.tid] * 1.4426950408889634f;
    for (int q = cx.tid; q < 64 * 65; q += 512) imp[q] = 0.f;
    if (cx.tid < 128) selm[cx.tid] = 0u;
    __syncthreads();
    LAS bf16_t* oab = (LAS bf16_t*)(L + AT_OACC) + (wave * 32) * 64 + cx.lane;
    { const bf16_t* KC = (const bf16_t*)(ws + OFF_KC) + (size_t)((b * 2 + kvh) * 256) * 64; const bf16_t* VCT = (const bf16_t*)(ws + OFF_VCT) + (size_t)((b * 2 + kvh) * 64) * 256;
      const int nt = ((4 * i + 2) >> 6) + 1;
      float m = -1e30f, l = 0.f; f32x16 O[2]; O[0] = zero16(); O[1] = zero16();
      attn_tiles<0, 0>(L, cx, KC, 64, VCT, 256, nt, 0, Qf, m, l, O);
      const float sc0 = l > 0.f ? gts[0] / l : 0.f;
#pragma unroll
      for (int r = 0; r < 16; ++r) { oab[r * 64] = f2bf(O[0][r] * sc0); oab[(16 + r) * 64] = f2bf(O[1][r] * sc0); }
#if (MK_REP >> 18) & 1
      { float m2 = -1e30f, l2 = 0.f; f32x16 O2[2]; O2[0] = zero16(); O2[1] = zero16(); attn_tiles<0, 0>(L, cx, KC, 64, VCT, 256, nt, 0, Qf, m2, l2, O2); asm volatile("" :: "v"(O2[0][0] + O2[1][5] + l2 + m2)); }
#endif
      attn_tiles<0, 1>(L, cx, KC, 64, VCT, 256, nt, 0, Qf, m, l, O);
    }
    __syncthreads();
    { const int q = cx.tid & 63, w8 = cx.tid >> 6; unsigned myk[8]; int cnt[8];
      LAS unsigned* impk = (LAS unsigned*)imp;
#pragma unroll
      for (int jj = 0; jj < 8; ++jj) { const int j = 8 * w8 + jj; const float v = imp[q * 65 + j] + ((j == 0 || j == i || j == i - 1) ? 1.0e4f : 0.f);
          myk[jj] = (__float_as_uint(v) & ~63u) | (unsigned)(63 - j); cnt[jj] = 0; }
#pragma unroll
      for (int jj = 0; jj < 8; ++jj) impk[q * 65 + 8 * w8 + jj] = myk[jj];
      __syncthreads();
      for (int j2 = 0; j2 <= i; ++j2) { const unsigned k2 = impk[q * 65 + j2];
#pragma unroll
          for (int jj = 0; jj < 8; ++jj) cnt[jj] += (k2 > myk[jj]) ? 1 : 0; }
      unsigned bits = 0u;
#pragma unroll
      for (int jj = 0; jj < 8; ++jj) { const int j = 8 * w8 + jj; if (j <= i && cnt[jj] < 16) bits |= 1u << jj; }
      __hip_atomic_fetch_or(selm + q * 2 + (w8 >> 2), bits << ((w8 & 3) * 8), __ATOMIC_RELAXED, __HIP_MEMORY_SCOPE_WORKGROUP);
    }
    __syncthreads();
    if (wave == 0) { unsigned u0 = selm[cx.lane * 2], u1 = selm[cx.lane * 2 + 1];
#pragma unroll
        for (int o = 32; o >= 1; o >>= 1) { u0 |= __shfl_xor(u0, o); u1 |= __shfl_xor(u1, o); }
        { const unsigned long long um = ((unsigned long long)u1 << 32) | u0;
          const int j = cx.lane; const bool on = (j <= i) && ((um >> j) & 1ull);
          if (on) tl[1 + __popcll(um & ((1ull << j) - 1ull))] = j;
          if (j == 0) tl[0] = __popcll(i >= 63 ? um : (um & ((1ull << (i + 1)) - 1ull))); } }
    __syncthreads();
    { const bf16_t* KS = P + ((size_t)b * SEQ) * NP + CKS + kvh * 64; const bf16_t* VTS = (const bf16_t*)(ws + OFF_VTS) + (size_t)((b * 2 + kvh) * 64) * SEQ;
      const int nt = tl[0];
      float m = -1e30f, l = 0.f; f32x16 O[2]; O[0] = zero16(); O[1] = zero16();
      attn_tiles<1, 0>(L, cx, KS, NP, VTS, SEQ, nt, 0, Qf, m, l, O);
      const float sc1 = l > 0.f ? gts[1] / l : 0.f;
#pragma unroll
      for (int r = 0; r < 16; ++r) { oab[r * 64] = f2bf(bf2f(oab[r * 64]) + O[0][r] * sc1); oab[(16 + r) * 64] = f2bf(bf2f(oab[(16 + r) * 64]) + O[1][r] * sc1); }
#if (MK_REP >> 19) & 1
      { float m2 = -1e30f, l2 = 0.f; f32x16 O2[2]; O2[0] = zero16(); O2[1] = zero16(); attn_tiles<1, 0>(L, cx, KS, NP, VTS, SEQ, nt, 0, Qf, m2, l2, O2); asm volatile("" :: "v"(O2[0][0] + O2[1][5] + l2 + m2)); }
#endif
    }
    { const bf16_t* KW = P + ((size_t)b * SEQ) * NP + CKW + kvh * 64; const bf16_t* VTW = (const bf16_t*)(ws + OFF_VTW) + (size_t)((b * 2 + kvh) * 64) * SEQ;
      const int j0 = i > 8 ? i - 8 : 0;
      float m = -1e30f, l = 0.f; f32x16 O[2]; O[0] = zero16(); O[1] = zero16();
      attn_tiles<2, 0>(L, cx, KW, NP, VTW, SEQ, i - j0 + 1, j0, Qf, m, l, O);
      const float sc2 = l > 0.f ? gts[2] / l : 0.f;
      bf16_t* ONSA = (bf16_t*)((unsigned char*)p.out + OUT_ONSA);
#pragma unroll
      for (int dt = 0; dt < 2; ++dt)
#pragma unroll
        for (int a = 0; a < 4; ++a) { float o4[4];
#pragma unroll
            for (int j = 0; j < 4; ++j) o4[j] = bf2f(oab[(16 * dt + 4 * a + j) * 64]) + O[dt][4 * a + j] * sc2;
            u32x2 wv; wv.x = pack2(o4[0], o4[1]); wv.y = pack2(o4[2], o4[3]);
            *(u32x2*)(ONSA + tokq * 512 + hq * 64 + 32 * dt + 8 * a + 4 * cx.hh) = wv; }
#if (MK_REP >> 20) & 1
      { float m2 = -1e30f, l2 = 0.f; f32x16 O2[2]; O2[0] = zero16(); O2[1] = zero16(); attn_tiles<2, 0>(L, cx, KW, NP, VTW, SEQ, i - j0 + 1, j0, Qf, m2, l2, O2); asm volatile("" :: "v"(O2[0][0] + O2[1][5] + l2 + m2)); }
#endif
    }
    __syncthreads();
}
template <int N> DI int dpp_rori(int v) { return __builtin_amdgcn_update_dpp(0, v, 0x120 + N, 0xF, 0xF, false); }
template <int N> DI float dpp_ror(float v) { return __uint_as_float((unsigned)__builtin_amdgcn_update_dpp(0, (int)__float_as_uint(v), 0x120 + N, 0xF, 0xF, false)); }
DI unsigned f2ord(float f) { const unsigned b = __float_as_uint(f); return (b & 0x80000000u) ? ~b : (b | 0x80000000u); }
DI float ord2f(unsigned u) { return __uint_as_float((u & 0x80000000u) ? (u & 0x7FFFFFFFu) : ~u); }
DI unsigned umax(unsigned a, unsigned b) { return a > b ? a : b; }
DI unsigned umin(unsigned a, unsigned b) { return a < b ? a : b; }
DI void ins16(unsigned (&t)[16], unsigned x) {
#pragma unroll
    for (int i = 0; i < 16; ++i) { const unsigned hi = umax(t[i], x); x = umin(t[i], x); t[i] = hi; } }
DI unsigned sel16(const unsigned (&v)[16], int i) { unsigned r = v[0];
#pragma unroll
    for (int j = 1; j < 16; ++j) { r = (i == j) ? v[j] : r; asm volatile("" : "+v"(r)); } return r; }
constexpr unsigned char BS_A[80] = {0,3,4,7,8,11,12,15,0,1,6,7,8,9,14,15,0,2,5,7,8,10,13,15,0,1,2,3,12,13,14,15,0,1,4,5,10,11,14,15,0,2,4,6,9,11,13,15,0,1,2,3,4,5,6,7,0,1,2,3,8,9,10,11,0,1,4,5,8,9,12,13,0,2,4,6,8,10,12,14};
constexpr unsigned char BS_B[80] = {1,2,5,6,9,10,13,14,2,3,4,5,10,11,12,13,1,3,4,6,9,11,12,14,4,5,6,7,8,9,10,11,2,3,6,7,8,9,12,13,1,3,5,7,8,10,12,14,8,9,10,11,12,13,14,15,4,5,6,7,12,13,14,15,2,3,6,7,10,11,14,15,1,3,5,7,9,11,13,15};
DI void sort16(unsigned (&v)[16]) {
#pragma unroll
    for (int n = 0; n < 80; ++n) { const unsigned hi = umax(v[BS_A[n]], v[BS_B[n]]), lo = umin(v[BS_A[n]], v[BS_B[n]]); v[BS_A[n]] = hi; v[BS_B[n]] = lo; } }
DI void bmerge16(unsigned (&v)[16]) {
#pragma unroll
    for (int n = 48; n < 80; ++n) { const unsigned hi = umax(v[BS_A[n]], v[BS_B[n]]), lo = umin(v[BS_A[n]], v[BS_B[n]]); v[BS_A[n]] = hi; v[BS_B[n]] = lo; } }
DI void route_half(const bf16_t* QRY, const bf16_t* KEYS, size_t tok, int hd, int half, int l31, int hh, unsigned (&top)[16]) {
    bf16x8 qf[4];
#pragma unroll
    for (int s = 0; s < 4; ++s) qf[s] = *(const bf16x8*)(QRY + tok * 1024 + hd * 128 + half * 64 + 16 * s + 8 * hh);
#pragma unroll
    for (int k = 0; k < 16; ++k) top[k] = 0u;
    const bf16_t* kp = KEYS + (size_t)(((half * 8 + hd) * 128) + l31) * 64 + 8 * hh;
#pragma unroll 1
    for (int kt = 0; kt < 4; ++kt) { f32x16 D = zero16();
        bf16x8 ac[4];
#pragma unroll
        for (int s = 0; s < 4; ++s) ac[s] = *(const bf16x8*)(kp + (size_t)(32 * kt) * 64 + 16 * s);
#pragma unroll
        for (int s = 0; s < 4; ++s) D = MFMA32(ac[s], qf[s], D);
        unsigned u[16];
#pragma unroll
        for (int r = 0; r < 16; ++r) { const int key = 32 * kt + crow(r, hh); u[r] = (f2ord(D[r]) & ~0x7Fu) | (unsigned)(127 - key); }
        sort16(u);
#pragma unroll
        for (int k = 0; k < 16; ++k) top[k] = umax(top[k], u[15 - k]);
        bmerge16(top); }
    unsigned cc[16];
#pragma unroll
    for (int k = 0; k < 16; ++k) cc[k] = (unsigned)__shfl_xor((int)top[k], 32);
#pragma unroll
    for (int k = 0; k < 16; ++k) top[k] = umax(top[k], cc[15 - k]);
    bmerge16(top);
}
#ifndef PE_AUX
#define PE_AUX 0
#endif
#ifndef GS_LOG
#define GS_LOG 2
#endif
constexpr int GSZ = 1 << GS_LOG, GSM = GSZ - 1;
constexpr int PSL_LOG = 4, PSL = 1 << PSL_LOG, PSL_SH = 14 - PSL_LOG;
constexpr int TPW = 8;
constexpr int PS_GRP = 256;
constexpr int PS_RIDX = 0, PS_RGATE = 16384, PS_SIDX = 32768, PS_SGS = PS_SIDX + 8 * PS_GRP * 8, PS_CNT = PS_SGS + 8 * PS_GRP * 16, PS_BASE = PS_CNT + 8 * 512, PS_GCNT = PS_BASE + 8 * 512, PS_KB = PS_GCNT + 8 * 512, PS_HQB = PS_KB + 8 * 64 * 32;
static_assert(PS_HQB + 8 * 4096 <= LDS_BYTES - LDS_USER, "PEER LDS layout");
DI int peer_dots(const u32x4 u0, const u32x4 u1, const u32x4 u2, const u32x4 u3, const u32x4 hqv) { const u32x4 nu[4] = {u0, u1, u2, u3};
    int d[4];
#pragma unroll
    for (int q = 0; q < 4; ++q) { int a = 0;
#pragma unroll
        for (int w = 0; w < 4; ++w) a = __builtin_amdgcn_sdot4((int)hqv[w], (int)nu[q][w], a, false);
        d[q] = a; }
    const auto pa = __builtin_amdgcn_permlane32_swap((unsigned)d[0], (unsigned)d[2], false, false); const unsigned k0 = pa[0] + pa[1];
    const auto pb = __builtin_amdgcn_permlane32_swap((unsigned)d[1], (unsigned)d[3], false, false); const unsigned k1 = pb[0] + pb[1];
    const auto pc = __builtin_amdgcn_permlane16_swap(k0, k1, false, false);
    return (int)(pc[0] + pc[1]);
}
DI int peer_rowsum(int kk) { kk += dpp_rori<8>(kk); kk += dpp_rori<4>(kk); kk += dpp_rori<2>(kk); kk += dpp_rori<1>(kk); return kk; }
DI float peer_gelu(const int kk, const unsigned mygs) {
    const float xg = (float)kk * bhi(mygs), ex = __builtin_amdgcn_exp2f(xg * __builtin_fmaf(xg * xg, -0.10294324f, -2.30220819f));
    return (blo(mygs) * xg) * __builtin_amdgcn_rcpf(1.0f + ex);
}
DI void peer_phase(const Params& p, LAS unsigned char* L, int bid, int nb) {
    const int tid = threadIdx.x, wave = __builtin_amdgcn_readfirstlane(tid >> 6);
    unsigned char* ws = p.ws;
    const bf16_t* QRY = (const bf16_t*)(ws + OFF_QRY); const bf16_t* KEYS = (const bf16_t*)(ws + OFF_KEYS); const bf16_t* H2 = (const bf16_t*)(ws + OFF_H2);
    const unsigned char* U8 = ws + OFF_UBF; const unsigned char* V8 = ws + OFF_VBF;
    const bf16_t* X1 = (const bf16_t*)(ws + OFF_X1); const float* mod = (const float*)(ws + OFF_MOD);
    LAS unsigned short* ridx = (LAS unsigned short*)(L + PS_RIDX); LAS bf16_t* rgate = (LAS bf16_t*)(L + PS_RGATE);
    LAS unsigned short* sidx = (LAS unsigned short*)(L + PS_SIDX) + wave * (PS_GRP * 4); LAS unsigned* sgs = (LAS unsigned*)(L + PS_SGS) + wave * (PS_GRP * 4);
    const float* USC = (const float*)(ws + OFF_USC);
    LAS int* cntl = (LAS int*)(L + PS_CNT) + wave * 128; LAS int* basel = (LAS int*)(L + PS_BASE) + wave * 128; LAS int* gcnt = (LAS int*)(L + PS_GCNT) + wave * 128;
    const int rot = (int)(((unsigned)PSL * xb_xcc_id() / 8u) & (unsigned)(PSL - 1));
    for (int tb = bid; tb < NTOK / (8 * TPW); tb += nb) {
        int lane = tid & 63; asm volatile("" : "+v"(lane));
        const int l31 = lane & 31, hh = lane >> 5;
#pragma unroll 1
        for (int task = wave; task < 2 * TPW; task += 8) { const int hd = task & 7, tt = task >> 3; const size_t tok = (size_t)tb * (8 * TPW) + tt * 32 + l31;
            unsigned v1[16], v2[16];
            route_half(QRY, KEYS, tok, hd, 0, l31, hh, v1);
            route_half(QRY, KEYS, tok, hd, 1, l31, hh, v2);
            unsigned t16[16];
#pragma unroll
            for (int k = 0; k < 16; ++k) t16[k] = 0u;
            { int cnt = 0; int pa1 = 0, pa2 = 0;
#pragma unroll
              for (int i1 = 0; i1 < 16; ++i1)
#pragma unroll
                for (int i2 = 0; i2 < 16; ++i2) if ((i1 + 1) * (i2 + 1) <= 16) {
                    if ((cnt & 1) == 0) { pa1 = i1; pa2 = i2; }
                    else { const float sa = ord2f(v1[pa1]) + ord2f(v2[pa2]), sb = ord2f(v1[i1]) + ord2f(v2[i2]);
                           const float sm = hh ? sb : sa; const unsigned ci = hh ? (unsigned)(255 - (i1 * 16 + i2)) : (unsigned)(255 - (pa1 * 16 + pa2));
                           ins16(t16, (f2ord(sm) & ~0xFFu) | ci); }
                    ++cnt; }
              unsigned cc[16];
#pragma unroll
              for (int k = 0; k < 16; ++k) cc[k] = (unsigned)__shfl_xor((int)t16[k], 32);
#pragma unroll
              for (int k = 0; k < 16; ++k) t16[k] = umax(t16[k], cc[15 - k]);
              bmerge16(t16); }
            const float mx = ord2f(t16[0]); float e[16]; float ssum = 0.f;
#pragma unroll
            for (int k = 0; k < 16; ++k) { e[k] = __expf(ord2f(t16[k]) - mx); ssum += e[k]; }
            const float rinv = __builtin_amdgcn_rcpf(ssum);
            { LAS unsigned char* kb = (LAS unsigned char*)(L + PS_KB) + (wave * 64 + lane) * 32;
#pragma unroll
              for (int w = 0; w < 4; ++w) { *(LAS unsigned*)(kb + 4 * w) = (v1[4 * w] & 0x7Fu) | ((v1[4 * w + 1] & 0x7Fu) << 8) | ((v1[4 * w + 2] & 0x7Fu) << 16) | ((v1[4 * w + 3] & 0x7Fu) << 24);
                                            *(LAS unsigned*)(kb + 16 + 4 * w) = (v2[4 * w] & 0x7Fu) | ((v2[4 * w + 1] & 0x7Fu) << 8) | ((v2[4 * w + 2] & 0x7Fu) << 16) | ((v2[4 * w + 3] & 0x7Fu) << 24); }
#pragma unroll
              for (int k = 0; k < 16; ++k) { const int ci = 255 - (int)(t16[k] & 0xFFu), i1 = ci >> 4, i2 = ci & 15;
                  const int k1 = 127 - (int)kb[i1], k2 = 127 - (int)kb[16 + i2];
                  if (hh == 0) { ridx[(tt * 32 + l31) * 128 + hd * 16 + k] = (unsigned short)(k1 * 128 + k2); rgate[(tt * 32 + l31) * 128 + hd * 16 + k] = f2bf(e[k] * rinv); } } }
        }
        __syncthreads();
        asm volatile("" : "+v"(lane));
        int hq[TPW][4]; float hsc[TPW];
#pragma unroll
        for (int j = 0; j < TPW; ++j) { const size_t tok = (size_t)tb * (8 * TPW) + TPW * wave + j; const u32x4 ha = *(const u32x4*)(H2 + tok * 1024 + lane * 16), hb = *(const u32x4*)(H2 + tok * 1024 + lane * 16 + 8);
            float hv[16]; hv[0] = blo(ha.x); hv[1] = bhi(ha.x); hv[2] = blo(ha.y); hv[3] = bhi(ha.y); hv[4] = blo(ha.z); hv[5] = bhi(ha.z); hv[6] = blo(ha.w); hv[7] = bhi(ha.w);
            hv[8] = blo(hb.x); hv[9] = bhi(hb.x); hv[10] = blo(hb.y); hv[11] = bhi(hb.y); hv[12] = blo(hb.z); hv[13] = bhi(hb.z); hv[14] = blo(hb.w); hv[15] = bhi(hb.w);
            float am = 0.f;
#pragma unroll
            for (int q = 0; q < 16; ++q) am = fmaxf(am, fabsf(hv[q]));
#pragma unroll
            for (int o = 32; o >= 1; o >>= 1) am = fmaxf(am, __shfl_xor(am, o));
            const float sc = am > 0.f ? 127.0f / am : 0.f; hsc[j] = am * (1.0f / 127.0f);
#pragma unroll
            for (int w = 0; w < 4; ++w) { const int b0 = (int)rintf(hv[4 * w] * sc), b1 = (int)rintf(hv[4 * w + 1] * sc), b2 = (int)rintf(hv[4 * w + 2] * sc), b3 = (int)rintf(hv[4 * w + 3] * sc);
                hq[j][w] = (int)((unsigned)(b0 & 0xFF) | ((unsigned)(b1 & 0xFF) << 8) | ((unsigned)(b2 & 0xFF) << 16) | ((unsigned)(b3 & 0xFF) << 24)); } }
        int total;
        { unsigned a0[TPW], a1[TPW], gs0[TPW], gs1[TPW]; int rk0[TPW], rk1[TPW];
          cntl[lane] = 0; cntl[64 + lane] = 0;
#pragma unroll
          for (int j = 0; j < TPW; ++j) { const int t = TPW * wave + j;
              a0[j] = ridx[t * 128 + lane]; a1[j] = ridx[t * 128 + 64 + lane];
              gs0[j] = (unsigned)rgate[t * 128 + lane] | ((unsigned)f2bf(USC[a0[j]] * hsc[j]) << 16); gs1[j] = (unsigned)rgate[t * 128 + 64 + lane] | ((unsigned)f2bf(USC[a1[j]] * hsc[j]) << 16);
              const int s0 = (int)(a0[j] >> PSL_SH), s1 = (int)(a1[j] >> PSL_SH);
              rk0[j] = __hip_atomic_fetch_add(cntl + j * 16 + s0, 1, __ATOMIC_RELAXED, __HIP_MEMORY_SCOPE_WAVEFRONT);
              rk1[j] = __hip_atomic_fetch_add(cntl + j * 16 + s1, 1, __ATOMIC_RELAXED, __HIP_MEMORY_SCOPE_WAVEFRONT); }
          const int qa = 2 * lane, qb = 2 * lane + 1, ja = qa & (TPW - 1), jb = qb & (TPW - 1), sa = ((qa >> 3) + rot) & (PSL - 1), sb = ((qb >> 3) + rot) & (PSL - 1);
          const int ca = cntl[ja * 16 + sa], cb = cntl[jb * 16 + sb];
          int ea = ca, eb = cb;
#pragma unroll
          for (int d = 4; d < 64; d <<= 1) { const int va = __shfl_up(ea, d), vb = __shfl_up(eb, d); ea += (lane >= d) ? va : 0; eb += (lane >= d) ? vb : 0; }
          const int Sa = ea - ca, Sb = eb - cb, c0a = (Sa + GSM) >> GS_LOG, c0b = (Sb + GSM) >> GS_LOG, ga = ((ea + GSM) >> GS_LOG) - c0a, gb = ((eb + GSM) >> GS_LOG) - c0b;
          int incl = ga + gb;
#pragma unroll
          for (int d = 1; d < 64; d <<= 1) { const int v = __shfl_up(incl, d); incl += (lane >= d) ? v : 0; }
          const int Ba = incl - ga - gb, Bb = incl - gb;
          int la = ga > 0 ? Ba + ga : 0, lb = gb > 0 ? Bb + gb : 0;
#pragma unroll
          for (int d = 4; d < 64; d <<= 1) { const int va = __shfl_up(la, d), vb = __shfl_up(lb, d); la = (lane >= d && va > la) ? va : la; lb = (lane >= d && vb > lb) ? vb : lb; }
          int pa = __shfl_up(la, 4), pb = __shfl_up(lb, 4); if (lane < 4) { pa = 0; pb = 0; }
          basel[ja * 16 + sa] = Sa | ((Ba - c0a + 64) << 8) | (pa << 20); basel[jb * 16 + sb] = Sb | ((Bb - c0b + 64) << 8) | (pb << 20); gcnt[qa] = ga; gcnt[qb] = gb;
          total = TPW * (128 >> GS_LOG);
#pragma unroll
          for (int j = 0; j < TPW; ++j) { const int s0 = (int)(a0[j] >> PSL_SH), s1 = (int)(a1[j] >> PSL_SH);
              const int w0 = basel[j * 16 + s0], w1 = basel[j * 16 + s1];
              const int S0 = w0 & 0xFF, S1 = w1 & 0xFF, t0 = S0 + rk0[j], t1 = S1 + rk1[j], g0 = t0 >> GS_LOG, g1 = t1 >> GS_LOG;
              const int G0 = (g0 >= ((S0 + GSM) >> GS_LOG)) ? (((w0 >> 8) & 0xFFF) - 64 + g0) : ((w0 >> 20) - 1), G1 = (g1 >= ((S1 + GSM) >> GS_LOG)) ? (((w1 >> 8) & 0xFFF) - 64 + g1) : ((w1 >> 20) - 1);
              const int p0 = G0 * GSZ + (t0 & GSM), p1 = G1 * GSZ + (t1 & GSM);
              const unsigned tg0 = (t0 & GSM) == 0 ? (unsigned)(j & 3) << 14 : (t0 & GSM) == 1 ? (unsigned)(j >> 2) << 14 : 0u, tg1 = (t1 & GSM) == 0 ? (unsigned)(j & 3) << 14 : (t1 & GSM) == 1 ? (unsigned)(j >> 2) << 14 : 0u;
              sidx[p0] = (unsigned short)(a0[j] | tg0); sgs[p0] = gs0[j]; sidx[p1] = (unsigned short)(a1[j] | tg1); sgs[p1] = gs1[j]; }
        }
        __syncthreads();
#pragma unroll
        for (int j = 0; j < TPW; ++j) *(LAS u32x4*)(L + ((j & 4) ? PS_HQB : 0) + wave * 4096 + (j & 3) * 1024 + lane * 16) = (u32x4){(unsigned)hq[j][0], (unsigned)hq[j][1], (unsigned)hq[j][2], (unsigned)hq[j][3]};
        f32x2 acc2[TPW][8];
#pragma unroll
        for (int j = 0; j < TPW; ++j)
#pragma unroll
            for (int q = 0; q < 8; ++q) acc2[j][q] = (f32x2){0.f, 0.f};
        const LAS unsigned* sidw = (const LAS unsigned*)sidx;
        const int lo16 = lane * 16;
        const __amdgpu_buffer_rsrc_t ursrc = __builtin_amdgcn_make_buffer_rsrc((void*)U8, 0, 16777216, 0x00020000), vrsrc = __builtin_amdgcn_make_buffer_rsrc((void*)V8, 0, 16777216, 0x00020000);
#define PE_LDU(ro) __builtin_bit_cast(u32x4, __builtin_amdgcn_raw_buffer_load_b128(ursrc, lo16, (int)(ro), PE_AUX))
#define PE_LDV(ro) __builtin_bit_cast(u32x4, __builtin_amdgcn_raw_buffer_load_b128(vrsrc, lo16, (int)(ro), PE_AUX))
#define PE_ROWS(w0, w1) const unsigned r0 = ((w0) & 0x3FFFu) << 10, r1 = (((w0) >> 16) & 0x3FFFu) << 10, r2 = ((w1) & 0x3FFFu) << 10, r3 = (((w1) >> 16) & 0x3FFFu) << 10
#define PE_HQ(w0) (*(const LAS u32x4*)(L + ((((w0) >> 30) & 1u) ? PS_HQB : 0) + wave * 4096 + (int)(((w0) >> 14) & 3u) * 1024 + lo16))
        const int lq = lane >> 4;
#if GS_LOG == 3
#define PE_ROWS8(w) const unsigned r0 = (w[0] & 0x3FFFu) << 10, r1 = ((w[0] >> 16) & 0x3FFFu) << 10, r2 = (w[1] & 0x3FFFu) << 10, r3 = ((w[1] >> 16) & 0x3FFFu) << 10, \
                                   r4 = (w[2] & 0x3FFFu) << 10, r5 = ((w[2] >> 16) & 0x3FFFu) << 10, r6 = (w[3] & 0x3FFFu) << 10, r7 = ((w[3] >> 16) & 0x3FFFu) << 10
#define PE_LDU8 { nu[0] = PE_LDU(r0); nu[1] = PE_LDU(r1); nu[2] = PE_LDU(r2); nu[3] = PE_LDU(r3); nu[4] = PE_LDU(r4); nu[5] = PE_LDU(r5); nu[6] = PE_LDU(r6); nu[7] = PE_LDU(r7); }
#define PE_LDV8 { nv[0] = PE_LDV(r0); nv[1] = PE_LDV(r1); nv[2] = PE_LDV(r2); nv[3] = PE_LDV(r3); nv[4] = PE_LDV(r4); nv[5] = PE_LDV(r5); nv[6] = PE_LDV(r6); nv[7] = PE_LDV(r7); }
        u32x4 nu[8], nv[8]; float cfA, cfB; unsigned wa[4];
        { unsigned w[4];
#pragma unroll
          for (int k = 0; k < 4; ++k) w[k] = (unsigned)__builtin_amdgcn_readfirstlane((int)sidw[k]);
          { PE_ROWS8(w); PE_LDU8 PE_LDV8 }
          const u32x4 hqv = PE_HQ(w[0]);
          cfA = peer_gelu(peer_rowsum(peer_dots(nu[0], nu[1], nu[2], nu[3], hqv)), sgs[lq]); cfB = peer_gelu(peer_rowsum(peer_dots(nu[4], nu[5], nu[6], nu[7], hqv)), sgs[4 + lq]);
#pragma unroll
          for (int k = 0; k < 4; ++k) wa[k] = (unsigned)__builtin_amdgcn_readfirstlane((int)sidw[4 + k]);
          { PE_ROWS8(wa); PE_LDU8 } }
        int gi = 0;
#pragma unroll 1
        for (int r = 0; r < PSL; ++r) {
#pragma unroll
            for (int j = 0; j < TPW; ++j) {
                const int cg = __builtin_amdgcn_readfirstlane(gcnt[r * TPW + j]);
#pragma unroll 1
                for (int g = 0; g < cg; ++g) {
                    unsigned wb[4] = {0u, 0u, 0u, 0u};
                    if (gi + 2 < total) {
#pragma unroll
                        for (int k = 0; k < 4; ++k) wb[k] = (unsigned)__builtin_amdgcn_readfirstlane((int)sidw[(gi + 2) * 4 + k]); }
                    const int gn = gi + 1 < total ? gi + 1 : gi;
                    const unsigned mygsA = sgs[gn * 8 + lq], mygsB = sgs[gn * 8 + 4 + lq];
                    const u32x4 hqv = PE_HQ(wa[0]);
                    int kkA = peer_dots(nu[0], nu[1], nu[2], nu[3], hqv), kkB = peer_dots(nu[4], nu[5], nu[6], nu[7], hqv);
#define PE_FMA8(cfx, q, row) { const float coef = __uint_as_float(__builtin_amdgcn_readlane(__float_as_uint(cfx), 16 * (q))); const f32x2 c2 = (f32x2){coef, coef}; const u32x4 a = nv[row]; \
                    _Pragma("unroll") for (int w = 0; w < 4; ++w) { const f32x2 lo = __builtin_amdgcn_cvt_pk_f32_fp8((int)a[w], false), hi = __builtin_amdgcn_cvt_pk_f32_fp8((int)a[w], true); \
                        acc2[j][2 * w] = __builtin_elementwise_fma(c2, lo, acc2[j][2 * w]); acc2[j][2 * w + 1] = __builtin_elementwise_fma(c2, hi, acc2[j][2 * w + 1]); } }
                    PE_FMA8(cfA, 0, 0)
                    kkA = peer_rowsum(kkA);
                    PE_FMA8(cfA, 1, 1)
                    kkB = peer_rowsum(kkB);
                    PE_FMA8(cfA, 2, 2)
                    const float cfnA = peer_gelu(kkA, mygsA);
                    PE_FMA8(cfA, 3, 3)
                    PE_FMA8(cfB, 0, 4)
                    const float cfnB = peer_gelu(kkB, mygsB);
                    PE_FMA8(cfB, 1, 5)
                    PE_FMA8(cfB, 2, 6)
                    PE_FMA8(cfB, 3, 7)
                    { PE_ROWS8(wb); PE_LDU8 }
                    { PE_ROWS8(wa); PE_LDV8 }
                    cfA = cfnA; cfB = cfnB;
#pragma unroll
                    for (int k = 0; k < 4; ++k) wa[k] = wb[k];
                    ++gi;
                }
            }
        }
#else
        u32x4 nu[4], nv[4]; float cf; unsigned wa0, wa1;
        { const unsigned w0 = (unsigned)__builtin_amdgcn_readfirstlane((int)sidw[0]), w1 = (unsigned)__builtin_amdgcn_readfirstlane((int)sidw[1]);
          { PE_ROWS(w0, w1);
            nu[0] = PE_LDU(r0); nu[1] = PE_LDU(r1); nu[2] = PE_LDU(r2); nu[3] = PE_LDU(r3); }
          cf = peer_gelu(peer_rowsum(peer_dots(nu[0], nu[1], nu[2], nu[3], PE_HQ(w0))), sgs[lq]);
          wa0 = (unsigned)__builtin_amdgcn_readfirstlane((int)sidw[2]); wa1 = (unsigned)__builtin_amdgcn_readfirstlane((int)sidw[3]);
          { PE_ROWS(wa0, wa1); nu[0] = PE_LDU(r0); nu[1] = PE_LDU(r1); nu[2] = PE_LDU(r2); nu[3] = PE_LDU(r3); }
          { PE_ROWS(w0, w1); nv[0] = PE_LDV(r0); nv[1] = PE_LDV(r1); nv[2] = PE_LDV(r2); nv[3] = PE_LDV(r3); } }
        int gi = 0;
#pragma unroll 1
        for (int r = 0; r < PSL; ++r) {
            const u32x4 gca = *(const LAS u32x4*)(gcnt + r * TPW), gcb = *(const LAS u32x4*)(gcnt + r * TPW + 4);
#pragma unroll
            for (int j = 0; j < TPW; ++j) {
                const int cg = __builtin_amdgcn_readfirstlane((int)(j < 4 ? gca[j & 3] : gcb[j & 3]));
#pragma unroll 1
                for (int g = 0; g < cg; ++g) {
                    const int g2 = gi + 2 < total ? gi + 2 : total - 1;
                    const u32x2 wbv = *(const LAS u32x2*)(sidw + g2 * 2);
                    const int gn = gi + 1 < total ? gi + 1 : gi;
                    const unsigned mygs = sgs[gn * 4 + lq];
                    const float cq[4] = {__uint_as_float(__builtin_amdgcn_readlane(__float_as_uint(cf), 0)), __uint_as_float(__builtin_amdgcn_readlane(__float_as_uint(cf), 16)),
                                         __uint_as_float(__builtin_amdgcn_readlane(__float_as_uint(cf), 32)), __uint_as_float(__builtin_amdgcn_readlane(__float_as_uint(cf), 48))};
                    int kk = peer_dots(nu[0], nu[1], nu[2], nu[3], PE_HQ(wa0));
#define PE_FMA(q) { const float coef = cq[q]; const f32x2 c2 = (f32x2){coef, coef}; const u32x4 a = nv[q]; \
                    _Pragma("unroll") for (int w = 0; w < 4; ++w) { const f32x2 lo = __builtin_amdgcn_cvt_pk_f32_fp8((int)a[w], false), hi = __builtin_amdgcn_cvt_pk_f32_fp8((int)a[w], true); \
                        acc2[j][2 * w] = __builtin_elementwise_fma(c2, lo, acc2[j][2 * w]); acc2[j][2 * w + 1] = __builtin_elementwise_fma(c2, hi, acc2[j][2 * w + 1]); } }
                    PE_FMA(0)
                    kk = peer_rowsum(kk);
                    PE_FMA(1)
                    const float cfn = peer_gelu(kk, mygs);
                    PE_FMA(2)
                    PE_FMA(3)
                    const unsigned wb0 = (unsigned)__builtin_amdgcn_readfirstlane((int)wbv[0]), wb1 = (unsigned)__builtin_amdgcn_readfirstlane((int)wbv[1]);
                    { PE_ROWS(wb0, wb1); nu[0] = PE_LDU(r0); nu[1] = PE_LDU(r1); nu[2] = PE_LDU(r2); nu[3] = PE_LDU(r3); }
                    { PE_ROWS(wa0, wa1); nv[0] = PE_LDV(r0); nv[1] = PE_LDV(r1); nv[2] = PE_LDV(r2); nv[3] = PE_LDV(r3); }
                    cf = cfn; wa0 = wb0; wa1 = wb1;
                    ++gi;
                }
            }
        }
#endif
#pragma unroll
        for (int j = 0; j < TPW; ++j) { const size_t tok = (size_t)tb * (8 * TPW) + TPW * wave + j;
            const bf16_t* xr = X1 + tok * 1024 + lane * 16; const float* g2 = mod + (size_t)(tok >> 12) * 6144 + 5120 + lane * 16; const float* fg = p.in[3] + lane * 16;
            const u32x4 xa = *(const u32x4*)xr, xb = *(const u32x4*)(xr + 8);
            float y[16]; float ss = 0.f;
#pragma unroll
            for (int q = 0; q < 4; ++q) { const unsigned w0 = (q < 2 ? xa : xb)[2 * (q & 1)], w1 = (q < 2 ? xa : xb)[2 * (q & 1) + 1];
                const f32x4 xv = (f32x4){blo(w0), bhi(w0), blo(w1), bhi(w1)}, gv = *(const f32x4*)(g2 + 4 * q);
#pragma unroll
                for (int c = 0; c < 4; ++c) { const float yy = xv[c] + gv[c] * acc2[j][q * 2 + (c >> 1)][c & 1]; y[q * 4 + c] = yy; ss += yy * yy; } }
            ss = wave_sum(ss); const float rstd = rsqrtf(ss * (1.0f / 1024.0f) + 1e-6f);
#pragma unroll
            for (int q = 0; q < 4; ++q) { const f32x4 fv = *(const f32x4*)(fg + 4 * q);
                f32x4 o; o[0] = y[q * 4] * rstd * fv[0]; o[1] = y[q * 4 + 1] * rstd * fv[1]; o[2] = y[q * 4 + 2] * rstd * fv[2]; o[3] = y[q * 4 + 3] * rstd * fv[3];
                *(f32x4*)(p.out + tok * 1024 + lane * 16 + 4 * q) = o; } }
        __syncthreads();
    }
}
#ifndef MK_REP
#define MK_REP 0
#endif
DI void run_p2(const Params& p, LAS unsigned char* L, int bid, int nb) { unsigned char* ws = p.ws; unsigned char* outb = (unsigned char*)p.out;
    pg8::Gemm g; g.A = (const bf16_t*)(outb + OUT_H1); g.Bt = (const bf16_t*)(ws + OFF_WIN); g.M = NTOK; g.N = NGEMM; g.K = 1024;
    pg8::StaticOrder S; S.init(g.M, g.N, nb, bid); pg8::EpiInproj E; E.O = (bf16_t*)(ws + OFF_P); E.ldc = NP; E.GT = (bf16_t*)(ws + OFF_GATES);
    pg8::gemm_phase<pg8::EpiInproj, pg8::StaticOrder, false>(L, g, S, E, nullptr); }
DI void run_p3(const Params& p, LAS unsigned char* L, int bid, int nb) {
#ifndef NO_P3A
    dn_prep(p, L, bid, nb);
#if (MK_REP >> 13) & 1
    dn_prep(p, L, bid, nb);
#endif
#endif
#ifndef NO_P3B
    for (int t = bid; t < 256; t += nb) compress_task(p, L, t);
#if (MK_REP >> 14) & 1
    for (int t = bid; t < 256; t += nb) compress_task(p, L, t);
#endif
#endif
#ifndef NO_P3C
    for (int u = bid; u < 512; u += nb) vtrans_unit(p, L, 4 * u);
#if (MK_REP >> 15) & 1
    for (int u = bid; u < 512; u += nb) vtrans_unit(p, L, 4 * u);
#endif
#endif
}
DI void run_p4(const Params& p, LAS unsigned char* lds, LAS unsigned char* L, int bid, int nb, int it) { const int tid = threadIdx.x;
#ifndef NO_P4A
    for (int bp = bid; bp < 32; bp += nb) dn_scan<2>(p, L, 2 * bp);
#if (MK_REP >> 11) & 1
    for (int bp = bid; bp < 32; bp += nb) dn_scan<2>(p, L, 2 * bp);
#endif
#endif
    LAS int* slot = (LAS int*)(lds + 32);
    { unsigned* ctr = (unsigned*)(p.ws + OFF_CTR) + (it * 8) * 64; const int x0 = (int)(xb_xcc_id() & 7u);
      for (int qi = 0; qi < 8; ++qi) { const int x = (x0 + qi) & 7;
        for (;;) { if (tid == 0) *slot = (int)atomicAdd(ctr + x * 64, 1u); __syncthreads(); const int n = *slot; __syncthreads(); if (n >= 128) break;
#ifndef NO_P4B
            attn_unit(p, L, ((n >> 1) << 4) | (2 * x + (n & 1)));
#endif
        } } }
#if (MK_REP >> 12) & 1
    { unsigned* ctr = (unsigned*)(p.ws + OFF_CTR) + 1000 + it * 8;
    for (;;) { if (tid == 0) *slot = (int)atomicAdd(ctr, 1u); __syncthreads(); const int u = *slot; __syncthreads(); if (u >= 1024) break;
        attn_unit(p, L, u);
    } }
#endif
}
DI void run_p5(const Params& p, LAS unsigned char* L, int bid, int nb) { unsigned char* ws = p.ws; unsigned char* outb = (unsigned char*)p.out;
    static_assert(OUT_ODN == OUT_ONSA + (size_t)NTOK * 512 * 2 && OFF_WD == OFF_WN + (size_t)1024 * 512 * 2, "the pair GEMM needs its operands stacked");
    pg8::Gemm g; g.A = (const bf16_t*)(outb + OUT_ONSA); g.Bt = (const bf16_t*)(ws + OFF_WN); g.M = NTOK; g.N = 1024; g.K = 512;
    pg8::PairOrder S; S.init(g.M, g.N, nb, bid);
    pg8::EpiGateFrag E; E.O = (bf16_t*)(outb + OUT_MRG); E.ldc = 1024; E.GT = (const bf16_t*)(ws + OFF_GATES); E.nM = NTOK / 256; E.nN = 4;
    pg8::gemm_phase<pg8::EpiGateFrag, pg8::PairOrder, false>(L, g, S, E, nullptr); }
DI void run_p7(const Params& p, LAS unsigned char* L, int bid, int nb) { unsigned char* ws = p.ws; unsigned char* outb = (unsigned char*)p.out;
    pg8::Gemm g; g.A = (const bf16_t*)(outb + OUT_MRG); g.Bt = (const bf16_t*)(ws + OFF_WO); g.M = NTOK; g.N = 1024; g.K = 1024;
    pg8::StaticOrder S; S.init(g.M, g.N, nb, bid); pg8::EpiResid E; E.X = p.in[0]; E.O = (bf16_t*)(ws + OFF_X1); E.mod = (const float*)(ws + OFF_MOD); E.goff = 2048;
    pg8::gemm_phase<pg8::EpiResid, pg8::StaticOrder, false>(L, g, S, E, nullptr); }
DI void run_p8(const Params& p, int bid, int nb) { unsigned char* ws = p.ws;
    norm_rows<true>((const void*)(ws + OFF_X1), p.in[20], (const float*)(ws + OFF_MOD), 3072, 4096, (bf16_t*)(ws + OFF_H2), bid, nb);
    cvt_i8_rows(p.in[24], ws + OFF_UBF, (float*)(ws + OFF_USC), 16384, bid, nb); cvt_fp8(p.in[25], ws + OFF_VBF, (size_t)16384 * 1024, 1.0f, bid, nb); }
DI void run_p9(const Params& p, LAS unsigned char* L, int bid, int nb) { unsigned char* ws = p.ws;
    pg8::Gemm g; g.A = (const bf16_t*)(ws + OFF_H2); g.Bt = (const bf16_t*)(ws + OFF_WQ); g.M = NTOK; g.N = 1024; g.K = 1024;
    pg8::StaticOrder S; S.init(g.M, g.N, nb, bid); pg8::EpiStore16 E; E.O = (bf16_t*)(ws + OFF_QRY); E.ldc = 1024;
    pg8::gemm_phase<pg8::EpiStore16, pg8::StaticOrder, false>(L, g, S, E, nullptr); }
#define REPEAT(k, call) { call; if (MK_REP & (1 << (k))) { call; } }
__global__ void __launch_bounds__(512, 2) mk_fwd(Params p, int lo, int hi) {
    extern __shared__ __attribute__((aligned(16))) unsigned char shm[];
    LAS unsigned char* lds = (LAS unsigned char*)shm;
    LAS unsigned char* L = lds + LDS_USER;
    const int bid = blockIdx.x, nb = gridDim.x, tid = threadIdx.x;
    unsigned char* ws = p.ws;
    const bool fused = (hi - lo) > 1;
    XcdBarrier bar; bar.bar = (unsigned*)ws; bar.x = 0; bar.st = (volatile LAS unsigned*)lds;
    if (fused) { if (tid == 0) { *(LAS u32x4*)lds = (u32x4){0u, 0u, 0u, 0u}; } __syncthreads(); bar = xcd_barrier_post((unsigned*)ws, (volatile LAS unsigned*)lds); }
    const float* mod = (const float*)(ws + OFF_MOD);
    unsigned char* outb = (unsigned char*)p.out;
#ifdef ONLY_PHASE
#define PHASE(k) if ((k) == ONLY_PHASE && lo <= (k) && (k) < hi)
#else
#define PHASE(k) if (lo <= (k) && (k) < hi)
#endif
#define SEAM(k) if (fused && lo <= (k) && (k) + 1 < hi) xcd_barrier(bar);
    PHASE(0) REPEAT(0, phase_prologue(p, L, bid, nb))
    SEAM(0)
    PHASE(1) REPEAT(1, norm_rows<false>(p.in[0], p.in[6], mod, 0, 1024, (bf16_t*)(outb + OUT_H1), bid, nb))
    SEAM(1)
    PHASE(2) REPEAT(2, run_p2(p, L, bid, nb))
    SEAM(2)
    PHASE(3) REPEAT(3, run_p3(p, L, bid, nb))
    SEAM(3)
    PHASE(4) { run_p4(p, lds, L, bid, nb, 0); if (MK_REP & (1 << 4)) { run_p4(p, lds, L, bid, nb, 1); } }
    SEAM(4)
    PHASE(5) REPEAT(5, run_p5(p, L, bid, nb))
    SEAM(5)
    PHASE(7) REPEAT(7, run_p7(p, L, bid, nb))
    SEAM(7)
    PHASE(8) REPEAT(8, run_p8(p, bid, nb))
    SEAM(8)
    PHASE(9) REPEAT(9, run_p9(p, L, bid, nb))
    SEAM(9)
    PHASE(10) REPEAT(10, peer_phase(p, L, bid, nb))
#undef PHASE
#undef SEAM
}
constexpr int N_PHASES = 11;
#ifndef MK_ONE_LAUNCH
#define MK_ONE_LAUNCH 1
#endif
extern "C" void kernel_launch(void* const* d_in, const int* in_sizes, int n_in, void* d_out, int out_size, void* d_ws, size_t ws_size, hipStream_t stream) {
    (void)in_sizes; (void)n_in; (void)out_size;
    static int grid = 0;
    if (!grid) {
        int dev = 0, cus = 0, per_cu = 0; hipGetDevice(&dev); hipDeviceGetAttribute(&cus, hipDeviceAttributeMultiprocessorCount, dev);
        hipFuncSetAttribute((const void*)mk_fwd, hipFuncAttributeMaxDynamicSharedMemorySize, LDS_BYTES);
        hipOccupancyMaxActiveBlocksPerMultiprocessor(&per_cu, (const void*)mk_fwd, 512, LDS_BYTES);
        if (per_cu < 1) { fprintf(stderr, "mk_fwd: occupancy query says 0 blocks per CU\n"); per_cu = 1; }
        grid = cus;
        if (ws_size < WS_NEED) fprintf(stderr, "mk_fwd: workspace too small (%zu < %zu)\n", ws_size, (size_t)WS_NEED);
    }
    hipMemsetAsync(d_ws, 0, 20480, stream);
    Params p{}; for (int i = 0; i < 26; ++i) p.in[i] = (const float*)d_in[i]; p.out = (float*)d_out; p.ws = (unsigned char*)d_ws;
#if MK_ONE_LAUNCH
    hipLaunchKernelGGL(mk_fwd, dim3(grid), dim3(512), LDS_BYTES, stream, p, 0, N_PHASES);
#else
    for (int k = 0; k < N_PHASES; ++k) hipLaunchKernelGGL(mk_fwd, dim3(grid), dim3(512), LDS_BYTES, stream, p, k, k + 1);
#endif
}
```

```cpp
#include <hip/hip_runtime.h>
#include <cstdio>
#include <cstdint>
#define MK_REP 0
namespace pg8 {
#define PG8_LAS __attribute__((address_space(3)))
typedef unsigned short bf16_t;
typedef short bf16x8 __attribute__((ext_vector_type(8)));
typedef float f32x4 __attribute__((ext_vector_type(4)));
typedef unsigned u32x4 __attribute__((ext_vector_type(4)));
constexpr int BM = 256, BK = 64, HALF = 128, HTB = HALF * BK * 2  , STAGE_BYTES = 8 * HTB, NXCD = 8, WGM = 4;

__host__ __device__ __forceinline__ int lds_byte(int r, int c) { const int st = (r >> 4) * 2 + (c >> 5), rr = r & 15, cc = c & 31, ob = rr * 64 + cc * 2; return st * 1024 + (ob ^ (((ob >> 9) & 1) << 5)); }
__host__ __device__ __forceinline__ void stage_rc(int b, int& R, int& C) { const int st = b / 1024, sb = b % 1024, swz = sb ^ (((sb >> 9) & 1) << 5); R = (st >> 1) * 16 + swz / 64; C = (st & 1) * 32 + (swz % 64) / 2; }
__host__ __device__ __forceinline__ int perm32(int rho) { const int n = rho >> 4, i = rho & 15; return 8 * (i >> 2) + 4 * n + (i & 3); }

struct Unit { int pm, pn; };
struct Gemm { const bf16_t* A; const bf16_t* Bt; int M, N, K; };

struct StaticOrder {
    int nM, nN, nwg, G, c;
    __host__ __device__ void init(int M, int N, int G_, int c_) { nM = M / BM; nN = N / BM; nwg = nM * nN; G = G_; c = c_; }
    __host__ __device__ bool next(int i, Unit& u) const {
        const long L = (long)i * G + c; if (L >= nwg) return false;
        int wgid = (int)L; { const int q = nwg / NXCD, r = nwg % NXCD, xcd = wgid % NXCD, off = wgid / NXCD; wgid = (xcd < r ? xcd * (q + 1) : r * (q + 1) + (xcd - r) * q) + off; }
        const int nig = WGM * nN, gid = wgid / nig, fm = gid * WGM, gsz = (nM - fm) < WGM ? (nM - fm) : WGM;
        u.pm = fm + ((wgid % nig) % gsz); u.pn = (wgid % nig) / gsz; return true;
    }
    __device__ __forceinline__ void a_ready(const Unit&) const {}
    __device__ __forceinline__ void done(const Unit&) const {}
};
__device__ __forceinline__ unsigned cvt_pk_bf16(float lo, float hi) { unsigned r; asm volatile("v_cvt_pk_bf16_f32 %0, %1, %2" : "=v"(r) : "v"(lo), "v"(hi)); return r; }
typedef float f32x2 __attribute__((ext_vector_type(2)));
struct EpiStore16 {
    static constexpr bool PERM = true, AFTER_DRAIN = false, IDEMP = true;
    bf16_t* O; int ldc;
    __device__ __forceinline__ void operator()(const f32x4 (&acc)[2][2][4][2], const Unit& u, int wr, int wc, int fr, int fq) const {
        const int row0 = u.pm * BM + wr * 64 + fr, col0 = u.pn * BM + wc * 32 + 8 * fq;
#pragma unroll
        for (int ai = 0; ai < 2; ++ai)
#pragma unroll
            for (int m = 0; m < 4; ++m) { bf16_t* rowp = O + (size_t)(row0 + ai * HALF + m * 16) * ldc + col0;
#pragma unroll
                for (int bj = 0; bj < 2; ++bj) { const f32x4 v0 = acc[ai][bj][m][0], v1 = acc[ai][bj][m][1];
                    u32x4 w; w.x = cvt_pk_bf16(v0[0], v0[1]); w.y = cvt_pk_bf16(v0[2], v0[3]); w.z = cvt_pk_bf16(v1[0], v1[1]); w.w = cvt_pk_bf16(v1[2], v1[3]);
                    *(u32x4*)(rowp + bj * HALF) = w; } }
    }
};
__device__ __forceinline__ float bfu_lo(unsigned w) { return __uint_as_float(w << 16); }
__device__ __forceinline__ float bfu_hi(unsigned w) { return __uint_as_float(w & 0xffff0000u); }
typedef __bf16 bf16v2e __attribute__((ext_vector_type(2)));
__device__ __forceinline__ unsigned pk2(float lo, float hi) { const f32x2 v = {lo, hi}; return __builtin_bit_cast(unsigned, __builtin_convertvector(v, bf16v2e)); }
__device__ __forceinline__ float sigm(float x) { return __builtin_amdgcn_rcpf(1.0f + __builtin_amdgcn_exp2f(-1.4426950408889634f * x)); }
template <bool ACCUM> struct EpiGate {
    static constexpr bool PERM = true, AFTER_DRAIN = false, IDEMP = false;
    bf16_t* O; int ldc; const bf16_t* G; int ldg;
    __device__ __forceinline__ void operator()(const f32x4 (&acc)[2][2][4][2], const Unit& u, int wr, int wc, int fr, int fq) const {
        const int row0 = u.pm * BM + wr * 64 + fr, col0 = u.pn * BM + wc * 32 + 8 * fq;
#pragma unroll
        for (int ai = 0; ai < 2; ++ai)
#pragma unroll
            for (int m = 0; m < 4; ++m) { const size_t row = (size_t)(row0 + ai * HALF + m * 16);
#pragma unroll
                for (int bj = 0; bj < 2; ++bj) { const f32x4 v0 = acc[ai][bj][m][0], v1 = acc[ai][bj][m][1];
                    const u32x4 gw = *(const u32x4*)(G + row * ldg + col0 + bj * HALF);
                    float r[8];
                    r[0] = sigm(bfu_lo(gw.x)) * v0[0]; r[1] = sigm(bfu_hi(gw.x)) * v0[1]; r[2] = sigm(bfu_lo(gw.y)) * v0[2]; r[3] = sigm(bfu_hi(gw.y)) * v0[3];
                    r[4] = sigm(bfu_lo(gw.z)) * v1[0]; r[5] = sigm(bfu_hi(gw.z)) * v1[1]; r[6] = sigm(bfu_lo(gw.w)) * v1[2]; r[7] = sigm(bfu_hi(gw.w)) * v1[3];
                    bf16_t* op = O + row * ldc + col0 + bj * HALF;
                    if (ACCUM) { const u32x4 ow = *(const u32x4*)op;
                        r[0] += bfu_lo(ow.x); r[1] += bfu_hi(ow.x); r[2] += bfu_lo(ow.y); r[3] += bfu_hi(ow.y); r[4] += bfu_lo(ow.z); r[5] += bfu_hi(ow.z); r[6] += bfu_lo(ow.w); r[7] += bfu_hi(ow.w); }
                    u32x4 w; w.x = cvt_pk_bf16(r[0], r[1]); w.y = cvt_pk_bf16(r[2], r[3]); w.z = cvt_pk_bf16(r[4], r[5]); w.w = cvt_pk_bf16(r[6], r[7]);
                    *(u32x4*)op = w; } }
    }
};
struct EpiResid {
    static constexpr bool PERM = true, AFTER_DRAIN = false, IDEMP = false;
    const float* X; bf16_t* O; const float* mod; int goff;
    __device__ __forceinline__ void operator()(const f32x4 (&acc)[2][2][4][2], const Unit& u, int wr, int wc, int fr, int fq) const {
        const int row0 = u.pm * BM + wr * 64 + fr, col0 = u.pn * BM + wc * 32 + 8 * fq;
        const float* gp = mod + (size_t)((u.pm * BM) >> 12) * 6144 + goff;
        f32x4 g[2][2];
#pragma unroll
        for (int bj = 0; bj < 2; ++bj) { g[bj][0] = *(const f32x4*)(gp + col0 + bj * HALF); g[bj][1] = *(const f32x4*)(gp + col0 + bj * HALF + 4); }
#pragma unroll
        for (int ai = 0; ai < 2; ++ai)
#pragma unroll
            for (int mh = 0; mh < 2; ++mh) {
                f32x4 x[2][2][2];
#pragma unroll
                for (int mm = 0; mm < 2; ++mm)
#pragma unroll
                    for (int bj = 0; bj < 2; ++bj) { const float* xp = X + (size_t)(row0 + ai * HALF + (2 * mh + mm) * 16) * 1024 + col0 + bj * HALF; x[mm][bj][0] = *(const f32x4*)xp; x[mm][bj][1] = *(const f32x4*)(xp + 4); }
#pragma unroll
                for (int mm = 0; mm < 2; ++mm)
#pragma unroll
                    for (int bj = 0; bj < 2; ++bj) { const int m = 2 * mh + mm; const size_t row = (size_t)(row0 + ai * HALF + m * 16);
                        const f32x4 r0 = x[mm][bj][0] + g[bj][0] * acc[ai][bj][m][0], r1 = x[mm][bj][1] + g[bj][1] * acc[ai][bj][m][1];
                        u32x4 w; w.x = cvt_pk_bf16(r0[0], r0[1]); w.y = cvt_pk_bf16(r0[2], r0[3]); w.z = cvt_pk_bf16(r1[0], r1[1]); w.w = cvt_pk_bf16(r1[2], r1[3]);
                        *(u32x4*)(O + row * 1024 + col0 + bj * HALF) = w; }
            }
    }
};
struct PairOrder : StaticOrder {
    __host__ __device__ bool next(int i, Unit& u) const {
        const long L = (long)i * G + c; if (L >= 2 * nwg) return false;
        const int half = L >= nwg ? 1 : 0; int wgid = (int)(L - (long)half * nwg);
        { const int q = nwg / NXCD, r = nwg % NXCD, xcd = wgid % NXCD, off = wgid / NXCD; wgid = (xcd < r ? xcd * (q + 1) : r * (q + 1) + (xcd - r) * q) + off; }
        const int nig = WGM * nN, gid = wgid / nig, fm = gid * WGM, gsz = (nM - fm) < WGM ? (nM - fm) : WGM;
        u.pm = fm + ((wgid % nig) % gsz) + half * nM; u.pn = (wgid % nig) / gsz + half * nN; return true;
    }
};
struct EpiGatePair {
    static constexpr bool PERM = true, AFTER_DRAIN = false, IDEMP = false;
    bf16_t* O; int ldc; const bf16_t* G0; const bf16_t* G1; int ldg; int nM, nN;
    __device__ __forceinline__ void operator()(const f32x4 (&acc)[2][2][4][2], const Unit& u, int wr, int wc, int fr, int fq) const {
        if (u.pn >= nN) { Unit v; v.pm = u.pm - nM; v.pn = u.pn - nN; EpiGate<true> e; e.O = O; e.ldc = ldc; e.G = G1; e.ldg = ldg; e(acc, v, wr, wc, fr, fq); }
        else { EpiGate<false> e; e.O = O; e.ldc = ldc; e.G = G0; e.ldg = ldg; e(acc, u, wr, wc, fr, fq); }
    }
};
struct EpiInproj {
    static constexpr bool PERM = true, AFTER_DRAIN = false, IDEMP = true;
    bf16_t* O; int ldc; bf16_t* GT;
    __device__ __forceinline__ void operator()(const f32x4 (&acc)[2][2][4][2], const Unit& u, int wr, int wc, int fr, int fq) const {
        if (u.pn >= 13 && u.pn < 21) {
            bf16_t* gp = GT + ((size_t)(u.pm * 8 + (u.pn - 13)) * 8192 + (size_t)(wr * 4 + wc) * 1024 + (fq * 16 + fr)) * 8;
#pragma unroll
            for (int ai = 0; ai < 2; ++ai)
#pragma unroll
                for (int m = 0; m < 4; ++m)
#pragma unroll
                    for (int bj = 0; bj < 2; ++bj) { const f32x4 v0 = acc[ai][bj][m][0], v1 = acc[ai][bj][m][1];
                        u32x4 w; w.x = pk2(sigm(v0[0]), sigm(v0[1])); w.y = pk2(sigm(v0[2]), sigm(v0[3])); w.z = pk2(sigm(v1[0]), sigm(v1[1])); w.w = pk2(sigm(v1[2]), sigm(v1[3]));
                        *(u32x4*)(gp + (size_t)(((ai * 4 + m) * 2 + bj) * 64) * 8) = w; }
        } else {
            Unit v = u; if (u.pn == 21) v.pn = 13;
            EpiStore16 e; e.O = O; e.ldc = ldc; e(acc, v, wr, wc, fr, fq);
        }
    }
};
struct EpiGateFrag {
    static constexpr bool PERM = true, AFTER_DRAIN = false, IDEMP = false;
    bf16_t* O; int ldc; const bf16_t* GT; int nM, nN;
    __device__ __forceinline__ void operator()(const f32x4 (&acc)[2][2][4][2], const Unit& u, int wr, int wc, int fr, int fq) const {
        const bool second = u.pn >= nN; const int pm = second ? u.pm - nM : u.pm, pn = second ? u.pn - nN : u.pn;
        const bf16_t* gp = GT + ((size_t)(pm * 8 + pn + (second ? 4 : 0)) * 8192 + (size_t)(wr * 4 + wc) * 1024 + (fq * 16 + fr)) * 8;
        const int row0 = pm * BM + wr * 64 + fr, col0 = pn * BM + wc * 32 + 8 * fq;
#pragma unroll
        for (int ai = 0; ai < 2; ++ai) {
            u32x4 gw[4][2], ow[4][2];
#pragma unroll
            for (int m = 0; m < 4; ++m)
#pragma unroll
                for (int bj = 0; bj < 2; ++bj) { gw[m][bj] = *(const u32x4*)(gp + (size_t)(((ai * 4 + m) * 2 + bj) * 64) * 8);
                    ow[m][bj] = (u32x4){0u, 0u, 0u, 0u};
                    if (second) ow[m][bj] = *(const u32x4*)(O + (size_t)(row0 + ai * HALF + m * 16) * ldc + col0 + bj * HALF); }
#pragma unroll
            for (int m = 0; m < 4; ++m) { const size_t row = (size_t)(row0 + ai * HALF + m * 16);
#pragma unroll
                for (int bj = 0; bj < 2; ++bj) { const f32x4 v0 = acc[ai][bj][m][0], v1 = acc[ai][bj][m][1]; const u32x4 g = gw[m][bj], o = ow[m][bj];
                    float r[8];
                    r[0] = bfu_lo(g.x) * v0[0] + bfu_lo(o.x); r[1] = bfu_hi(g.x) * v0[1] + bfu_hi(o.x); r[2] = bfu_lo(g.y) * v0[2] + bfu_lo(o.y); r[3] = bfu_hi(g.y) * v0[3] + bfu_hi(o.y);
                    r[4] = bfu_lo(g.z) * v1[0] + bfu_lo(o.z); r[5] = bfu_hi(g.z) * v1[1] + bfu_hi(o.z); r[6] = bfu_lo(g.w) * v1[2] + bfu_lo(o.w); r[7] = bfu_hi(g.w) * v1[3] + bfu_hi(o.w);
                    u32x4 w; w.x = cvt_pk_bf16(r[0], r[1]); w.y = cvt_pk_bf16(r[2], r[3]); w.z = cvt_pk_bf16(r[4], r[5]); w.w = cvt_pk_bf16(r[6], r[7]);
                    *(u32x4*)(O + row * ldc + col0 + bj * HALF) = w; } }
        }
    }
};
template <class Epi, class Sched, bool STAMP = false>
__device__ __forceinline__ void gemm_phase(PG8_LAS unsigned char* lds, const Gemm g, const Sched& S, const Epi& E, unsigned long long* stamps) {
    const int tid = threadIdx.x, wid = __builtin_amdgcn_readfirstlane(tid >> 6), lane = tid & 63, wr = wid >> 2, wc = wid & 3, fr = lane & 15, fq = lane >> 4;
    const int K = g.K, nt = K / BK;
    int ts_lo = 0, ts_hi = 0, nts = 0; const unsigned long long rt_entry = STAMP ? (unsigned long long)wall_clock64() : 0ull;
#define PG8_STAMP() do { if (STAMP && wid == 0 && nts < 64) { const unsigned long long _c = (unsigned long long)clock64(); \
        ts_lo = (lane == nts) ? (int)(unsigned)_c : ts_lo; ts_hi = (lane == nts) ? (int)(unsigned)(_c >> 32) : ts_hi; ++nts; } } while (0)
    PG8_STAMP();
    unsigned voffA[2], voffB[2];
#pragma unroll
    for (int i = 0; i < 2; ++i) { int R, C; stage_rc(tid * 16 + i * 8192, R, C); const int Rb = Epi::PERM ? ((R & ~31) + perm32(R & 31)) : R;
        voffA[i] = (unsigned)(R * K + C) * 2u; voffB[i] = (unsigned)(Rb * K + C) * 2u; }
    const size_t kstep = (size_t)(BK * 2);
    const size_t hstep = (size_t)HALF * K * 2;
    const size_t tstep = 2 * hstep;
    const unsigned ldsw = (unsigned)wid * 1024u;
    const int aoff = lds_byte(wr * 64 + fr, fq * 8), boff = lds_byte(wc * 32 + fr, fq * 8);
#define PG8_SA(b, h) (((b) * 2 + (h)) * HTB)
#define PG8_SB(b, h) ((4 + (b) * 2 + (h)) * HTB)
#define PG8_STAGE(bufoff, gbase, voff) do { _Pragma("unroll") for (int _i = 0; _i < 2; ++_i) \
        __builtin_amdgcn_global_load_lds((const unsigned*)((const char*)(gbase) + (voff)[_i]), (PG8_LAS unsigned*)(lds + (bufoff) + ldsw + _i * 8192), 16, 0, 0); } while (0)
#define PG8_LDA(dst, b, h) do { _Pragma("unroll") for (int m = 0; m < 4; ++m) _Pragma("unroll") for (int k = 0; k < 2; ++k) dst[m][k] = *(const PG8_LAS bf16x8*)(lds + PG8_SA(b, h) + aoff + m * 2048 + k * 1024); } while (0)
#define PG8_LDB(dst, b, h) do { _Pragma("unroll") for (int n = 0; n < 2; ++n) _Pragma("unroll") for (int k = 0; k < 2; ++k) dst[n][k] = *(const PG8_LAS bf16x8*)(lds + PG8_SB(b, h) + boff + n * 2048 + k * 1024); } while (0)
#define PG8_MMA(ai, bj, At, Bt) do { __builtin_amdgcn_s_setprio(1); _Pragma("unroll") for (int m = 0; m < 4; ++m) _Pragma("unroll") for (int n = 0; n < 2; ++n) _Pragma("unroll") for (int k = 0; k < 2; ++k) \
        acc[ai][bj][m][n] = __builtin_amdgcn_mfma_f32_16x16x32_bf16(Bt[n][k], At[m][k], acc[ai][bj][m][n], 0, 0, 0); __builtin_amdgcn_s_setprio(0); } while (0)
#define PG8_WAIT_V(n) asm volatile("s_waitcnt vmcnt(" #n ")" ::: "memory")
#define PG8_WAIT_L(n) asm volatile("s_waitcnt lgkmcnt(" #n ")" ::: "memory")
#define PG8_BAR __builtin_amdgcn_s_barrier()
#define PG8_SCHED __builtin_amdgcn_sched_barrier(0)
    Unit cur, nxt; int ui = 0;
    if (!S.next(0, cur)) return;
    f32x4 acc[2][2][4][2];
#pragma unroll
    for (int a = 0; a < 2; ++a)
#pragma unroll
        for (int b = 0; b < 2; ++b)
#pragma unroll
            for (int m = 0; m < 4; ++m)
#pragma unroll
                for (int n = 0; n < 2; ++n) acc[a][b][m][n] = (f32x4){0.f, 0.f, 0.f, 0.f};
    bf16x8 At[4][2], B0[2][2], B1[2][2];
    const char* cA = (const char*)g.A + (size_t)cur.pm * tstep; const char* cB = (const char*)g.Bt + (size_t)cur.pn * tstep;
    S.a_ready(cur);
    PG8_STAGE(PG8_SB(0, 0), cB, voffB); PG8_STAGE(PG8_SA(0, 0), cA, voffA); PG8_STAGE(PG8_SB(0, 1), cB + hstep, voffB); PG8_STAGE(PG8_SA(0, 1), cA + hstep, voffA);
    if (wr == 1) PG8_BAR;
    PG8_WAIT_V(4); PG8_BAR;
    PG8_STAGE(PG8_SB(1, 0), cB + kstep, voffB); PG8_STAGE(PG8_SA(1, 0), cA + kstep, voffA); PG8_STAGE(PG8_SB(1, 1), cB + hstep + kstep, voffB);
    PG8_WAIT_V(6); PG8_BAR;
    PG8_STAMP();
    for (;;) {
        const bool has_next = S.next(ui + 1, nxt);
        const char* nA = has_next ? (const char*)g.A + (size_t)nxt.pm * tstep : cA; const char* nB = has_next ? (const char*)g.Bt + (size_t)nxt.pn * tstep : cB;
        for (int t = 0; t < nt; t += 2) {
            const bool last = (t == nt - 2);
            const char* a1 = cA + (size_t)(t + 1) * kstep;
            const char* a2 = last ? nA : cA + (size_t)(t + 2) * kstep; const char* b2 = last ? nB : cB + (size_t)(t + 2) * kstep;
            const char* a3 = a2 + kstep; const char* b3 = b2 + kstep;
            if (last && has_next) S.a_ready(nxt);
            PG8_LDB(B0, 0, 0); PG8_SCHED; PG8_LDA(At, 0, 0); PG8_STAGE(PG8_SA(1, 1), a1 + hstep, voffA);
            PG8_WAIT_L(8); PG8_BAR; PG8_WAIT_L(0); PG8_MMA(0, 0, At, B0); PG8_BAR; PG8_SCHED;
            PG8_LDB(B1, 0, 1); PG8_STAGE(PG8_SB(0, 0), b2, voffB);
            PG8_BAR; PG8_WAIT_L(0); PG8_MMA(0, 1, At, B1); PG8_BAR;
            PG8_LDA(At, 0, 1); PG8_STAGE(PG8_SA(0, 0), a2, voffA);
            PG8_BAR; PG8_WAIT_L(0); PG8_MMA(1, 0, At, B0); PG8_BAR; PG8_SCHED;
            PG8_STAGE(PG8_SB(0, 1), b2 + hstep, voffB);
            PG8_WAIT_V(6); PG8_BAR; PG8_MMA(1, 1, At, B1); PG8_BAR;
            PG8_LDB(B0, 1, 0); PG8_SCHED; PG8_LDA(At, 1, 0); PG8_STAGE(PG8_SA(0, 1), a2 + hstep, voffA);
            PG8_WAIT_L(8); PG8_BAR; PG8_WAIT_L(0); PG8_MMA(0, 0, At, B0); PG8_BAR; PG8_SCHED;
            PG8_LDB(B1, 1, 1); PG8_STAGE(PG8_SB(1, 0), b3, voffB);
            PG8_BAR; PG8_WAIT_L(0); PG8_MMA(0, 1, At, B1); PG8_BAR;
            PG8_LDA(At, 1, 1); PG8_STAGE(PG8_SA(1, 0), a3, voffA);
            PG8_BAR; PG8_WAIT_L(0); PG8_MMA(1, 0, At, B0); PG8_BAR; PG8_SCHED;
            PG8_STAGE(PG8_SB(1, 1), b3 + hstep, voffB);
            PG8_WAIT_V(6); PG8_BAR; PG8_MMA(1, 1, At, B1); PG8_BAR;
        }
        PG8_STAMP();
        if constexpr (!Epi::AFTER_DRAIN) { E(acc, cur, wr, wc, fr, fq);
#if (MK_REP >> 25) & 1
            if constexpr (Epi::IDEMP) E(acc, cur, wr, wc, fr, fq);
#endif
            S.done(cur); }
        PG8_STAMP();
        if (!has_next) break;
#pragma unroll
        for (int a = 0; a < 2; ++a)
#pragma unroll
            for (int b = 0; b < 2; ++b)
#pragma unroll
                for (int m = 0; m < 4; ++m)
#pragma unroll
                    for (int n = 0; n < 2; ++n) acc[a][b][m][n] = (f32x4){0.f, 0.f, 0.f, 0.f};
        cur = nxt; cA = nA; cB = nB; ++ui;
    }
    PG8_WAIT_V(0);
    if (wr == 0) PG8_BAR;
    PG8_BAR;
    if constexpr (Epi::AFTER_DRAIN) { E.fused(acc, cur, wr, wc, fr, fq, lds, wid, lane); S.done(cur); }
    PG8_STAMP();
    if (STAMP && wid == 0) { stamps[lane] = lane < nts ? (((unsigned long long)(unsigned)ts_hi << 32) | (unsigned)ts_lo) : 0ull;
        if (lane == 62) stamps[62] = rt_entry; if (lane == 63) stamps[63] = (unsigned long long)wall_clock64(); }
#undef PG8_STAMP
#undef PG8_SA
#undef PG8_SB
#undef PG8_STAGE
#undef PG8_LDA
#undef PG8_LDB
#undef PG8_MMA
#undef PG8_WAIT_V
#undef PG8_WAIT_L
#undef PG8_BAR
#undef PG8_SCHED
}
}
#define XB_TMO      128
#define XB_XCNT(j)  (256  + 64 * (j))
#define XB_XSUB(j)  (1280 + 64 * (j))
#define XB_XGEN(j)  (2304 + 64 * (j))
#define XB_TOP      3328
#define XB_TOPGEN   3392
#define XCD_BAR_WORDS 3456
#define XB_SPIN_CAP (1u << 18)
#define LAS __attribute__((address_space(3)))

__device__ __forceinline__ unsigned xb_ld(unsigned* p)              { return __hip_atomic_load(p, __ATOMIC_RELAXED, __HIP_MEMORY_SCOPE_AGENT); }
__device__ __forceinline__ unsigned xb_add(unsigned* p, unsigned v) { return __hip_atomic_fetch_add(p, v, __ATOMIC_RELAXED, __HIP_MEMORY_SCOPE_AGENT); }
__device__ __forceinline__ unsigned xb_xcc_id() { return (unsigned)__builtin_amdgcn_s_getreg((3 << 11) | 20) & 0xFu; }
#define XB_SPIN(cond, bar) do { unsigned _sp = 0; while (cond) { __builtin_amdgcn_s_sleep(1); \
    if ((++_sp & 255u) == 0u) { if (xb_ld(&(bar)[XB_TMO])) break; if (_sp > XB_SPIN_CAP) { atomicAdd(&(bar)[XB_TMO], 1u); break; } } } } while (0)

struct XcdBarrier {
    unsigned* bar; unsigned x;
    volatile LAS unsigned* st;
};

__device__ __forceinline__ XcdBarrier xcd_barrier_post(unsigned* bar, volatile LAS unsigned* st) {
    XcdBarrier b; b.bar = bar; b.x = xb_xcc_id(); b.st = st;
    if (threadIdx.x == 0) (void)xb_add(&bar[XB_XCNT(b.x)], 1u);
    return b;
}
__device__ __forceinline__ void xcd_barrier_complete(unsigned* bar, unsigned x, unsigned& nloc, unsigned& nx) {
    const unsigned G = gridDim.x * gridDim.y * gridDim.z;
    unsigned sum, cnt, mine, sp = 0u;
    for (;;) {
        sum = 0u; cnt = 0u; mine = 0u;
#pragma unroll
        for (unsigned j = 0; j < 16; ++j) { const unsigned c = xb_ld(&bar[XB_XCNT(j)]); sum += c; cnt += (c > 0u) ? 1u : 0u; mine = (j == x) ? c : mine; }
        if (sum == G) break;
        __builtin_amdgcn_s_sleep(1);
        if ((++sp & 255u) == 0u) { if (xb_ld(&bar[XB_TMO])) break; if (sp > XB_SPIN_CAP) { atomicAdd(&bar[XB_TMO], 1u); break; } }
    }
    nloc = mine > 0u ? mine : 1u; nx = cnt > 0u ? cnt : 1u;
}

__device__ __forceinline__ void xcd_barrier(const XcdBarrier& b) {
    asm volatile("s_waitcnt vmcnt(0)" ::: "memory");
    __syncthreads();
    if (threadIdx.x == 0) {
        unsigned* bar = b.bar;
        __builtin_amdgcn_s_waitcnt(0);
        unsigned nloc = b.st[0], nx = b.st[1];
        if (nloc == 0u) { xcd_barrier_complete(bar, b.x, nloc, nx); b.st[0] = nloc; b.st[1] = nx; }
        const unsigned old = xb_add(&bar[XB_XSUB(b.x)], 1u);
        const unsigned gen = old / nloc;
        if (old + 1u == (gen + 1u) * nloc) {
            __builtin_amdgcn_fence(__ATOMIC_RELEASE, "agent");
            asm volatile("s_waitcnt vmcnt(0)" ::: "memory");
            const unsigned og = xb_add(&bar[XB_TOP], 1u);
            const unsigned tg = og / nx;
            if (og + 1u == (tg + 1u) * nx) xb_add(&bar[XB_TOPGEN], 1u);
            else XB_SPIN(xb_ld(&bar[XB_TOPGEN]) == tg, bar);
            __builtin_amdgcn_fence(__ATOMIC_ACQUIRE, "agent");
            xb_add(&bar[XB_XGEN(b.x)], 1u);
            asm volatile("s_waitcnt vmcnt(0)" ::: "memory");
        } else {
            XB_SPIN(xb_ld(&bar[XB_XGEN(b.x)]) == gen, bar);
            __builtin_amdgcn_fence(__ATOMIC_ACQUIRE, "agent");
            asm volatile("s_waitcnt vmcnt(0)" ::: "memory");
        }
    }
    __syncthreads();
}
#ifndef MK_REP
#define MK_REP 0
#endif
#define DI __device__ __forceinline__
typedef unsigned short bf16_t;
typedef short bf16x8 __attribute__((ext_vector_type(8)));
typedef float f32x4 __attribute__((ext_vector_type(4)));
typedef float f32x16 __attribute__((ext_vector_type(16)));
typedef unsigned u32x4 __attribute__((ext_vector_type(4)));
typedef unsigned u32x2 __attribute__((ext_vector_type(2)));

constexpr int NTOK = 32768, DM = 1024, SEQ = 4096;
constexpr int NGEMM = 5632;
constexpr int NP = 3584;
constexpr int CQ = 0, CKC = 512, CVC = 640, CKS = 768, CVS = 896, CKW = 1024, CVW = 1152, CDQ = 1280, CDK = 1792, CDV = 2304, CZ = 2816, CNG = 3328, CB = 3352, CA = 3360;
constexpr size_t OFF_CTR = 16384, OFF_MOD = 20480, OFF_C1 = 217088, OFF_BTAB = 217600, OFF_GL = 221696;
constexpr size_t OFF_WIN = 262144, OFF_WN = 11796480, OFF_WD = 12845056, OFF_WO = 13893632, OFF_WQ = 15990784;
constexpr size_t OFF_W1K = 18087936, OFF_W1V = 18350080, OFF_W2K = 18612224, OFF_W2V = 18620416, OFF_KEYS = 18628608;
constexpr size_t OFF_KC = 18890752, OFF_VCT = 19415040, OFF_VTS = 19939328, OFF_VTW = 28327936;
constexpr size_t OFF_P = 37748736;
constexpr size_t OFF_GATES = OFF_P + (size_t)NTOK * NP * 2;
constexpr size_t OFF_WF = 406847488, OFF_UF = OFF_WF + 33554432, OFF_AF = OFF_UF + 33554432;
constexpr size_t WS_NEED = OFF_AF + 33554432;
constexpr size_t OFF_X1 = OFF_P, OFF_H2 = OFF_P + 134217728, OFF_QRY = OFF_H2 + 67108864, OFF_UBF = OFF_QRY + 67108864, OFF_VBF = OFF_UBF + 33554432, OFF_USC = OFF_UBF + 16777216;
constexpr size_t OUT_H1 = 0, OUT_QF = 0, OUT_KF = 33554432, OUT_MRG = 0, OUT_ONSA = 67108864, OUT_ODN = 100663296;
constexpr int LDS_BYTES = 147456, LDS_USER = 256;

struct Params { const float* in[26]; float* out; unsigned char* ws; };

DI float bf2f(bf16_t b) { return __uint_as_float(((unsigned)b) << 16); }
DI float blo(unsigned w) { return __uint_as_float(w << 16); }
DI float bhi(unsigned w) { return __uint_as_float(w & 0xffff0000u); }
DI bf16_t f2bf(float f) { unsigned u = __float_as_uint(f); u += 0x7FFFu + ((u >> 16) & 1u); return (bf16_t)(u >> 16); }
typedef __bf16 bf16v2_t __attribute__((ext_vector_type(2)));
typedef float f32x2 __attribute__((ext_vector_type(2)));
DI unsigned pack2(float lo, float hi) { const f32x2 v = {lo, hi}; return __builtin_bit_cast(unsigned, __builtin_convertvector(v, bf16v2_t)); }
DI bf16x8 pack8(const f32x16& v, int s) {
    u32x4 p; p.x = pack2(v[8 * s], v[8 * s + 1]); p.y = pack2(v[8 * s + 2], v[8 * s + 3]); p.z = pack2(v[8 * s + 4], v[8 * s + 5]); p.w = pack2(v[8 * s + 6], v[8 * s + 7]);
    return __builtin_bit_cast(bf16x8, p);
}
DI f32x16 zero16() { f32x16 z;
#pragma unroll
    for (int i = 0; i < 16; ++i) z[i] = 0.f; return z; }
#define MFMA32(a, b, c) __builtin_amdgcn_mfma_f32_32x32x16_bf16((a), (b), (c), 0, 0, 0)
DI int crow(int r, int hh) { return 8 * (r >> 2) + 4 * hh + (r & 3); }
DI float wave_sum(float v) { v += __shfl_xor(v, 32); v += __shfl_xor(v, 16); v += __shfl_xor(v, 8); v += __shfl_xor(v, 4); v += __shfl_xor(v, 2); v += __shfl_xor(v, 1); return v; }
DI float sigmf(float x) { return __builtin_amdgcn_rcpf(1.0f + __builtin_amdgcn_exp2f(-1.4426950408889634f * x)); }
DI float siluf(float x) { return x * sigmf(x); }
DI float gelu_tanh(float x) { const float u = 0.7978845608028654f * (x + 0.044715f * x * x * x); return x * sigmf(2.0f * u); }
DI int vperm16(int j) { return (j & 3) + 4 * (j >> 3) + 8 * ((j >> 2) & 1); }

DI int winmap(int n) {
    if (n < 1280) return n;
    if (n < 3328) return n + 24;
    if (n < 5376) return n + 40;
    if (n < 5400) return n - 5376 + 1280;
    if (n < 5408) return n - 5400 + 3352;
    if (n < 5416) return n - 5408 + 3360;
    return -1;
}
DI void cvt_tile(const float* src, int ld, bf16_t* dst, int K, int kt, int nt, bool usemap, LAS float* T) {
    const int tid = threadIdx.x;
    { const int r = tid >> 4, c4 = (tid & 15) * 4;
#pragma unroll
      for (int ps = 0; ps < 2; ++ps) { const int k = kt * 64 + r + 32 * ps, n = nt * 64 + c4; const int sc = usemap ? winmap(n) : n;
          f32x4 v = (f32x4){0.f, 0.f, 0.f, 0.f}; if (sc >= 0) v = *(const f32x4*)(src + (size_t)k * ld + sc);
          LAS float* tp = T + (r + 32 * ps) * 65 + c4; tp[0] = v[0]; tp[1] = v[1]; tp[2] = v[2]; tp[3] = v[3]; } }
    __syncthreads();
    { const int n = tid >> 3, kc = (tid & 7) * 8; float v[8];
#pragma unroll
      for (int j = 0; j < 8; ++j) v[j] = T[(kc + j) * 65 + n];
      u32x4 w; w.x = pack2(v[0], v[1]); w.y = pack2(v[2], v[3]); w.z = pack2(v[4], v[5]); w.w = pack2(v[6], v[7]);
      *(u32x4*)(dst + (size_t)(nt * 64 + n) * K + kt * 64 + kc) = w; }
    __syncthreads();
}
DI void cvt_flat(const float* src, bf16_t* dst, size_t n, int bid, int nb) {
    for (size_t i = ((size_t)bid * 512 + threadIdx.x) * 8; i < n; i += (size_t)nb * 512 * 8) {
        const f32x4 a = *(const f32x4*)(src + i), b = *(const f32x4*)(src + i + 4);
        u32x4 w; w.x = pack2(a[0], a[1]); w.y = pack2(a[2], a[3]); w.z = pack2(b[0], b[1]); w.w = pack2(b[2], b[3]);
        *(u32x4*)(dst + i) = w; }
}
DI void cvt_fp8(const float* src, unsigned char* dst, size_t n, float scale, int bid, int nb) {
    for (size_t i = ((size_t)bid * 512 + threadIdx.x) * 16; i < n; i += (size_t)nb * 512 * 16) {
        u32x4 w;
#pragma unroll
        for (int q = 0; q < 4; ++q) { const f32x4 a = *(const f32x4*)(src + i + 4 * q) * scale;
            int v = __builtin_amdgcn_cvt_pk_fp8_f32(a[0], a[1], 0, false); v = __builtin_amdgcn_cvt_pk_fp8_f32(a[2], a[3], v, true); w[q] = (unsigned)v; }
        *(u32x4*)(dst + i) = w; }
}
DI void cvt_i8_rows(const float* src, unsigned char* dst, float* scale, int nrows, int bid, int nb) {
    const int wave = threadIdx.x >> 6, lane = threadIdx.x & 63;
    for (int row = bid * 8 + wave; row < nrows; row += nb * 8) {
        const float* sp = src + (size_t)row * 1024 + lane * 16; f32x4 v[4]; float am = 0.f;
#pragma unroll
        for (int q = 0; q < 4; ++q) { v[q] = *(const f32x4*)(sp + 4 * q); am = fmaxf(am, fmaxf(fmaxf(fabsf(v[q][0]), fabsf(v[q][1])), fmaxf(fabsf(v[q][2]), fabsf(v[q][3])))); }
#pragma unroll
        for (int o = 32; o >= 1; o >>= 1) am = fmaxf(am, __shfl_xor(am, o));
        const float sc = am > 0.f ? 127.0f / am : 0.f;
        u32x4 w;
#pragma unroll
        for (int q = 0; q < 4; ++q) { const int b0 = (int)rintf(v[q][0] * sc), b1 = (int)rintf(v[q][1] * sc), b2 = (int)rintf(v[q][2] * sc), b3 = (int)rintf(v[q][3] * sc);
            w[q] = (unsigned)(b0 & 0xFF) | ((unsigned)(b1 & 0xFF) << 8) | ((unsigned)(b2 & 0xFF) << 16) | ((unsigned)(b3 & 0xFF) << 24); }
        *(u32x4*)(dst + (size_t)row * 1024 + lane * 16) = w;
        if (lane == 0) scale[row] = am * (1.0f / 127.0f);
    }
}
DI void phase_prologue(const Params& p, LAS unsigned char* L, int bid, int nb) {
    const int tid = threadIdx.x;
    unsigned char* ws = p.ws;
    for (int cb = bid; cb < 192; cb += nb) {
        LAS float* cond = (LAS float*)L; LAS float* red = (LAS float*)(L + 32768);
        for (int i = tid; i < 8192; i += 512) cond[i] = siluf(p.in[1][i]);
        __syncthreads();
        const int cl = tid & 31, ks = tid >> 5, n = cb * 32 + cl;
        const float* w = p.in[4] + (size_t)(ks * 64) * 6144 + n;
        float acc[8];
#pragma unroll
        for (int b = 0; b < 8; ++b) acc[b] = 0.f;
        for (int k = 0; k < 64; ++k) { const float wv = w[(size_t)k * 6144];
#pragma unroll
            for (int b = 0; b < 8; ++b) acc[b] += cond[b * 1024 + ks * 64 + k] * wv; }
#pragma unroll
        for (int b = 0; b < 8; ++b) red[(ks * 8 + b) * 32 + cl] = acc[b];
        __syncthreads();
        if (tid < 256) { const int b = tid >> 5, c2 = tid & 31; float s = p.in[5][cb * 32 + c2];
            for (int k2 = 0; k2 < 16; ++k2) s += red[(k2 * 8 + b) * 32 + c2];
            ((float*)(ws + OFF_MOD))[b * 6144 + cb * 32 + c2] = s; }
        __syncthreads();
    }
    for (int t = bid; t < 2242; t += nb) {
        LAS float* T = (LAS float*)L;
        if (t < 1408) cvt_tile(p.in[7], 5416, (bf16_t*)(ws + OFF_WIN), 1024, t / 88, t % 88, true, T);
        else if (t < 1536) { const int u = t - 1408; cvt_tile(p.in[17], 1024, (bf16_t*)(ws + OFF_WN), 512, u / 16, u % 16, false, T); }
        else if (t < 1664) { const int u = t - 1536; cvt_tile(p.in[18], 1024, (bf16_t*)(ws + OFF_WD), 512, u / 16, u % 16, false, T); }
        else if (t < 1920) { const int u = t - 1664; cvt_tile(p.in[19], 1024, (bf16_t*)(ws + OFF_WO), 1024, u / 16, u % 16, false, T); }
        else if (t < 2176) { const int u = t - 1920; cvt_tile(p.in[21], 1024, (bf16_t*)(ws + OFF_WQ), 1024, u / 16, u % 16, false, T); }
        else if (t < 2208) { const int u = t - 2176; cvt_tile(p.in[9], 64, (bf16_t*)(ws + OFF_W1K), 2048, u, 0, false, T); }
        else if (t < 2240) { const int u = t - 2208; cvt_tile(p.in[11], 64, (bf16_t*)(ws + OFF_W1V), 2048, u, 0, false, T); }
        else if (t == 2240) cvt_tile(p.in[10], 64, (bf16_t*)(ws + OFF_W2K), 64, 0, 0, false, T);
        else cvt_tile(p.in[12], 64, (bf16_t*)(ws + OFF_W2V), 64, 0, 0, false, T);
    }
    cvt_flat(p.in[22], (bf16_t*)(ws + OFF_KEYS), 65536, bid, nb);
    cvt_flat(p.in[23], (bf16_t*)(ws + OFF_KEYS) + 65536, 65536, bid, nb);
    for (int wch = 0; wch < 2; ++wch) if (bid == (200 + wch) % nb) {
        LAS float* red = (LAS float*)L; const float* w1 = p.in[wch ? 11 : 9]; const float* pos = p.in[8];
        const int j = tid & 63, ks = tid >> 6; float s = 0.f;
        for (int e = ks * 256; e < ks * 256 + 256; ++e) s += pos[e] * w1[(size_t)e * 64 + j];
        red[ks * 64 + j] = s; __syncthreads();
        if (tid < 64) { float t2 = 0.f; for (int k2 = 0; k2 < 8; ++k2) t2 += red[k2 * 64 + tid]; ((float*)(ws + OFF_C1))[wch * 64 + tid] = t2; }
        __syncthreads();
    }
    if (bid == 202 % nb) {
        for (int i = tid; i < 1024; i += 512) { const int h = i >> 7, d = i & 127; int bk;
            if (d < 16) bk = d; else { const float sc = logf((float)d / 16.0f) / logf(8.0f); bk = 16 + (int)(sc * 16.0f); if (bk > 31) bk = 31; }
            ((float*)(ws + OFF_BTAB))[i] = p.in[2][bk * 8 + h]; }
    }
}
template <bool SRC_BF16>
DI void norm_rows(const void* srcv, const float* g, const float* mod, int shoff, int scoff, bf16_t* dst, int bid, int nb) {
    const int wave = threadIdx.x >> 6, lane = threadIdx.x & 63;
    for (int t0 = (bid * 8 + wave) * 16; t0 < NTOK; t0 += nb * 8 * 16) {
        const float* mb = mod + (size_t)(t0 >> 12) * 6144;
        f32x4 gs[4], sh[4];
#pragma unroll
        for (int q = 0; q < 4; ++q) { const int c = (q >> 1) * 512 + lane * 8 + (q & 1) * 4;
            const f32x4 gg = *(const f32x4*)(g + c), sc = *(const f32x4*)(mb + scoff + c); sh[q] = *(const f32x4*)(mb + shoff + c);
            gs[q] = gg * (sc + 1.0f); }
#pragma unroll 2
        for (int tk = 0; tk < 16; ++tk) { const int tok = t0 + tk;
            f32x4 v[4];
            if (SRC_BF16) { const bf16_t* xr = (const bf16_t*)srcv + (size_t)tok * DM; const u32x4 a = *(const u32x4*)(xr + lane * 8), b = *(const u32x4*)(xr + 512 + lane * 8);
                v[0] = (f32x4){blo(a.x), bhi(a.x), blo(a.y), bhi(a.y)}; v[1] = (f32x4){blo(a.z), bhi(a.z), blo(a.w), bhi(a.w)}; v[2] = (f32x4){blo(b.x), bhi(b.x), blo(b.y), bhi(b.y)}; v[3] = (f32x4){blo(b.z), bhi(b.z), blo(b.w), bhi(b.w)};
            } else { const float* xr = (const float*)srcv + (size_t)tok * DM;
                v[0] = *(const f32x4*)(xr + lane * 8); v[1] = *(const f32x4*)(xr + lane * 8 + 4); v[2] = *(const f32x4*)(xr + 512 + lane * 8); v[3] = *(const f32x4*)(xr + 512 + lane * 8 + 4); }
            float ss = 0.f;
#pragma unroll
            for (int q = 0; q < 4; ++q) ss += v[q][0] * v[q][0] + v[q][1] * v[q][1] + v[q][2] * v[q][2] + v[q][3] * v[q][3];
            ss = wave_sum(ss); const float rstd = rsqrtf(ss * (1.0f / 1024.0f) + 1e-6f);
            f32x4 y[4];
#pragma unroll
            for (int q = 0; q < 4; ++q) y[q] = (v[q] * rstd) * gs[q] + sh[q];
            u32x4 w0, w1; w0.x = pack2(y[0][0], y[0][1]); w0.y = pack2(y[0][2], y[0][3]); w0.z = pack2(y[1][0], y[1][1]); w0.w = pack2(y[1][2], y[1][3]);
            w1.x = pack2(y[2][0], y[2][1]); w1.y = pack2(y[2][2], y[2][3]); w1.z = pack2(y[3][0], y[3][1]); w1.w = pack2(y[3][2], y[3][3]);
            *(u32x4*)(dst + (size_t)tok * DM + lane * 8) = w0; *(u32x4*)(dst + (size_t)tok * DM + 512 + lane * 8) = w1; }
    }
}
constexpr int DNU_LDS = 35840;
DI void dn_prep(const Params& p, LAS unsigned char* L, int bid, int nb) {
    const int tid = threadIdx.x, sub = tid >> 7;
    unsigned char* ws = p.ws;
    const bf16_t* P = (const bf16_t*)(ws + OFF_P);
    bf16_t* QF = (bf16_t*)((unsigned char*)p.out + OUT_QF); bf16_t* KF = (bf16_t*)((unsigned char*)p.out + OUT_KF);
    bf16_t* WF = (bf16_t*)(ws + OFF_WF); bf16_t* UF = (bf16_t*)(ws + OFF_UF); bf16_t* AF = (bf16_t*)(ws + OFF_AF); float* GL = (float*)(ws + OFF_GL);
    const float* conv_w = p.in[13];
    LAS unsigned char* UB = L + sub * DNU_LDS;
    LAS bf16_t* qn = (LAS bf16_t*)UB; LAS bf16_t* kn = (LAS bf16_t*)(UB + 9216); LAS float* Am = (LAS float*)(UB + 18432);
    LAS float* sbeta = (LAS float*)(UB + 34816); LAS float* sgc = sbeta + 64; LAS float* sg = sbeta + 128;
    LAS float* cwl = (LAS float*)(L + 4 * DNU_LDS);
    int hcur = -1;
    for (int ub = bid; ub < 1024; ub += nb) {
        int tau = tid & 127; asm volatile("" : "+v"(tau));
        const int lane = tau & 63, wu = tau >> 6, l31 = lane & 31, hh = lane >> 5;
        const int un = ub * 4 + sub, c = un & 63, h = (un >> 6) & 7, b = un >> 9;
        { const int h0 = ((ub * 4) >> 6) & 7;
          if (h0 != hcur) { __syncthreads(); for (int q = tid; q < 768; q += 512) { const int i = q / 192, rr = q % 192; cwl[q] = conv_w[i * 1536 + (rr >> 6) * 512 + h0 * 64 + (rr & 63)]; } hcur = h0; __syncthreads(); } }
        const size_t tok0 = (size_t)b * SEQ + c * 64, uoff = (size_t)un * 4096;
        u32x4 rawr[2][5];
#pragma unroll
        for (int part = 0; part < 2; ++part)
#pragma unroll
            for (int q5 = 0; q5 < 5; ++q5) { const int pc = tau + 128 * q5, r = pc >> 3, ch = pc & 7; rawr[part][q5] = (u32x4){0u, 0u, 0u, 0u};
                if (pc < 67 * 8 && c * 64 + r - 3 >= 0) rawr[part][q5] = *(const u32x4*)(P + (tok0 + r - 3) * NP + (part ? CDK : CDQ) + h * 64 + ch * 8); }
        if (tau < 64) { const size_t tok = tok0 + tau; const float a = bf2f(P[tok * NP + CA + h]), bl = bf2f(P[tok * NP + CB + h]);
            const float x = a + p.in[15][h]; const float sp = x > 20.f ? x : log1pf(__expf(x));
            sg[tau] = -__expf(p.in[14][h]) * sp; sbeta[tau] = sigmf(bl); }
        __syncthreads();
        if (tau < 64) { int tq = tau; asm volatile("" : "+v"(tq));
            float s = 0.f; for (int j = 0; j < 64; ++j) { const float gj = sg[j]; s += (j <= tq) ? gj : 0.f; } sgc[tau] = s; }
        __syncthreads();
#pragma unroll
        for (int rp2 = 0; rp2 < 1 + ((MK_REP >> 21) & 1); ++rp2)
        { const int t = tau >> 1, hf = tau & 1; const float gct = sgc[t]; const float eq = __expf(gct), ek = __expf(sgc[63] - gct);
          LAS bf16_t* raw = (LAS bf16_t*)Am;
#pragma unroll
          for (int part = 0; part < 2; ++part) {
            __syncthreads();
#pragma unroll
            for (int q5 = 0; q5 < 5; ++q5) { const int pc = tau + 128 * q5, r = pc >> 3, ch = pc & 7; if (pc < 67 * 8) *(LAS u32x4*)(raw + r * 72 + ch * 8) = rawr[part][q5]; }
            __syncthreads();
            float y[32];
#pragma unroll
            for (int v = 0; v < 4; ++v) { float a8[8];
#pragma unroll
                for (int j = 0; j < 8; ++j) a8[j] = 0.f;
#pragma unroll
                for (int i = 0; i < 4; ++i) {
                    const u32x4 rw = *(const LAS u32x4*)(raw + (t + i) * 72 + hf * 32 + v * 8);
                    const LAS float* cw = cwl + (i * 3 + part) * 64 + hf * 32 + v * 8; const f32x4 w0 = *(const LAS f32x4*)cw, w1 = *(const LAS f32x4*)(cw + 4);
                    a8[0] += w0[0] * blo(rw.x); a8[1] += w0[1] * bhi(rw.x); a8[2] += w0[2] * blo(rw.y); a8[3] += w0[3] * bhi(rw.y);
                    a8[4] += w1[0] * blo(rw.z); a8[5] += w1[1] * bhi(rw.z); a8[6] += w1[2] * blo(rw.w); a8[7] += w1[3] * bhi(rw.w); }
#pragma unroll
                for (int j = 0; j < 8; ++j) y[v * 8 + j] = siluf(a8[j]); }
            float ss = 0.f;
#pragma unroll
            for (int d = 0; d < 32; ++d) ss += y[d] * y[d];
            ss += __shfl_xor(ss, 1);
            const float rn = rsqrtf(ss + 1e-6f) * (part == 0 ? 0.125f : 1.0f);
#pragma unroll
            for (int d = 0; d < 32; ++d) y[d] *= rn;
            LAS bf16_t* tile = part ? kn : qn;
#pragma unroll
            for (int v = 0; v < 4; ++v) { u32x4 w; w.x = pack2(y[v * 8], y[v * 8 + 1]); w.y = pack2(y[v * 8 + 2], y[v * 8 + 3]); w.z = pack2(y[v * 8 + 4], y[v * 8 + 5]); w.w = pack2(y[v * 8 + 6], y[v * 8 + 7]);
                *(LAS u32x4*)(tile + t * 72 + hf * 32 + v * 8) = w; }
            if (part == 0) {
#pragma unroll
                for (int s2 = 0; s2 < 2; ++s2)
#pragma unroll
                    for (int hp = 0; hp < 2; ++hp) { const int o = 16 * s2 + 4 * hp; u32x4 w;
                        w.x = pack2(y[o] * eq, y[o + 1] * eq); w.y = pack2(y[o + 2] * eq, y[o + 3] * eq); w.z = pack2(y[o + 8] * eq, y[o + 9] * eq); w.w = pack2(y[o + 10] * eq, y[o + 11] * eq);
                        *(u32x4*)(QF + uoff + (size_t)((((t >> 5) * 4 + 2 * hf + s2) * 64 + (t & 31) + 32 * hp) * 8)) = w; }
            }
          }
          sg[t] = ek; }
        __syncthreads();
#pragma unroll
        for (int rp3 = 0; rp3 < 1 + ((MK_REP >> 22) & 1); ++rp3)
#pragma unroll
        for (int q = 0; q < 4; ++q) { const int pid = tau + 128 * q, rt = pid >> 8, s = (pid >> 6) & 3, lp = pid & 63, kap = 32 * rt + (lp & 31), hp = lp >> 5; float e8[8];
#pragma unroll
            for (int e = 0; e < 8; ++e) { const int te = 16 * s + 8 * (e >> 2) + 4 * hp + (e & 3); e8[e] = bf2f(kn[te * 72 + kap]) * sg[te]; }
            u32x4 w; w.x = pack2(e8[0], e8[1]); w.y = pack2(e8[2], e8[3]); w.z = pack2(e8[4], e8[5]); w.w = pack2(e8[6], e8[7]);
            *(u32x4*)(KF + uoff + (size_t)pid * 8) = w; }
#pragma unroll
        for (int rp4 = 0; rp4 < 1 + ((MK_REP >> 23) & 1); ++rp4)
        { bf16x8 kf[2][4], qf[4];
#pragma unroll
          for (int rt = 0; rt < 2; ++rt)
#pragma unroll
            for (int s = 0; s < 4; ++s) kf[rt][s] = *(const LAS bf16x8*)(kn + (32 * rt + l31) * 72 + 16 * s + 8 * hh);
#pragma unroll
          for (int s = 0; s < 4; ++s) qf[s] = *(const LAS bf16x8*)(qn + (32 * wu + l31) * 72 + 16 * s + 8 * hh);
          f32x16 dk[2], da[2]; dk[0] = zero16(); dk[1] = zero16(); da[0] = zero16(); da[1] = zero16();
#pragma unroll
          for (int s = 0; s < 4; ++s) { const bf16x8 kb = wu ? kf[1][s] : kf[0][s];
              dk[0] = MFMA32(kf[0][s], kb, dk[0]); dk[1] = MFMA32(kf[1][s], kb, dk[1]);
              da[0] = MFMA32(kf[0][s], qf[s], da[0]); da[1] = MFMA32(kf[1][s], qf[s], da[1]); }
          int jc = 32 * wu + l31; asm volatile("" : "+v"(jc)); const float gcj = sgc[jc];
#pragma unroll
          for (int it = 0; it < 2; ++it)
#pragma unroll
            for (int r = 0; r < 16; ++r) { const int i = 32 * it + crow(r, hh); float v = 0.f;
                if (i > jc) v = sbeta[i] * dk[it][r] * __expf(sgc[i] - gcj);
                Am[i * 64 + jc] = v; }
#pragma unroll
          for (int jt = 0; jt < 2; ++jt)
#pragma unroll
            for (int s2 = 0; s2 < 2; ++s2) { float e8[8];
#pragma unroll
                for (int e = 0; e < 8; ++e) { const int r = 8 * s2 + e, j = 32 * jt + crow(r, hh); e8[e] = (jc >= j) ? da[jt][r] * __expf(gcj - sgc[j]) : 0.f; }
                u32x4 w; w.x = pack2(e8[0], e8[1]); w.y = pack2(e8[2], e8[3]); w.z = pack2(e8[4], e8[5]); w.w = pack2(e8[6], e8[7]);
                *(u32x4*)(AF + uoff + (size_t)(((wu * 4 + 2 * jt + s2) * 64 + lane) * 8)) = w; }
        }
        __syncthreads();
#pragma unroll
        for (int rp5 = 0; rp5 < 1 + ((MK_REP >> 24) & 1); ++rp5)
        { float x[64];
          if (tau < 64) { const int colv = CDV + h * 64 + tau;
              const float w0 = cwl[128 + tau], w1 = cwl[192 + 128 + tau], w2 = cwl[384 + 128 + tau], w3 = cwl[576 + 128 + tau];
              float x0 = 0.f, x1 = 0.f, x2 = 0.f;
              if (c > 0) { x0 = bf2f(P[(tok0 - 3) * NP + colv]); x1 = bf2f(P[(tok0 - 2) * NP + colv]); x2 = bf2f(P[(tok0 - 1) * NP + colv]); }
              const bf16_t* pv = P + tok0 * NP + colv;
#pragma unroll
              for (int i = 0; i < 64; ++i) { const float x3 = bf2f(*pv); pv += NP; asm volatile("" : "+v"(pv));
                  const float yv = w0 * x0 + w1 * x1 + w2 * x2 + w3 * x3;
                  x[i] = siluf(yv) * sbeta[i]; x0 = x1; x1 = x2; x2 = x3; }
          } else { const int kk = tau - 64;
#pragma unroll
              for (int i = 0; i < 64; ++i) x[i] = bf2f(kn[i * 72 + kk]) * sbeta[i] * __expf(sgc[i]); }
          f32x4 an[16];
          an[0] = *(const LAS f32x4*)(Am + 64);
#pragma unroll
          for (int i = 1; i < 64; ++i) { f32x4 ac[16];
#pragma unroll
              for (int j4 = 0; j4 < (i + 3) / 4; ++j4) ac[j4] = an[j4];
              if (i + 1 < 64) {
#pragma unroll
                  for (int j4 = 0; j4 < (i + 4) / 4; ++j4) an[j4] = *(const LAS f32x4*)(Am + (i + 1) * 64 + 4 * j4); }
              __builtin_amdgcn_sched_barrier(0);
              float s0 = x[i], s1 = 0.f, s2 = 0.f, s3 = 0.f;
#pragma unroll
              for (int j4 = 0; j4 < (i + 3) / 4; ++j4) { const f32x4 a = ac[j4];
                  s0 -= a[0] * x[4 * j4]; s1 -= a[1] * x[4 * j4 + 1]; s2 -= a[2] * x[4 * j4 + 2]; s3 -= a[3] * x[4 * j4 + 3]; }
              x[i] = (s0 + s1) + (s2 + s3); }
          if (tau < 64) { const int slice = tau >> 5;
#pragma unroll
              for (int rt = 0; rt < 2; ++rt)
#pragma unroll
                for (int hp = 0; hp < 2; ++hp) { u32x4 wa, wb; const int o = 32 * rt + 4 * hp;
                    wa.x = pack2(x[o], x[o + 1]); wa.y = pack2(x[o + 2], x[o + 3]); wa.z = pack2(x[o + 8], x[o + 9]); wa.w = pack2(x[o + 10], x[o + 11]);
                    wb.x = pack2(x[o + 16], x[o + 17]); wb.y = pack2(x[o + 18], x[o + 19]); wb.z = pack2(x[o + 24], x[o + 25]); wb.w = pack2(x[o + 26], x[o + 27]);
                    bf16_t* dp = UF + uoff + (size_t)((((slice * 2 + rt) * 64) + (tau & 31) + 32 * hp) * 16);
                    *(u32x4*)dp = wa; *(u32x4*)(dp + 8) = wb; }
          } else { const int kk = tau - 64;
#pragma unroll
              for (int i = 0; i < 64; ++i) qn[i * 72 + kk] = f2bf(x[i]); }
        }
        __syncthreads();
#pragma unroll
        for (int q = 0; q < 4; ++q) { const int pid = tau + 128 * q, rt = pid >> 8, s = (pid >> 6) & 3, lp = pid & 63, row = 32 * rt + (lp & 31), hp = lp >> 5;
            const u32x2 lo = *(const LAS u32x2*)(qn + row * 72 + 16 * s + 4 * hp), hi = *(const LAS u32x2*)(qn + row * 72 + 16 * s + 8 + 4 * hp);
            u32x4 w; w.x = lo.x; w.y = lo.y; w.z = hi.x; w.w = hi.y;
            *(u32x4*)(WF + uoff + (size_t)pid * 8) = w; }
        if (tau == 0) GL[un] = __expf(sgc[63]);
        __syncthreads();
    }
}
constexpr int DNS_LDS = 57600;
template <int NB>
DI void dn_scan(const Params& p, LAS unsigned char* L, int bh0) {
    const int tid = threadIdx.x, wave = tid >> 6, lane = tid & 63, l31 = lane & 31, hh = lane >> 5;
    unsigned char* ws = p.ws;
    const bf16_t* P = (const bf16_t*)(ws + OFF_P);
    const bf16_t* src[5] = { (const bf16_t*)(ws + OFF_WF), (const bf16_t*)((unsigned char*)p.out + OUT_KF), (const bf16_t*)((unsigned char*)p.out + OUT_QF), (const bf16_t*)(ws + OFF_AF), (const bf16_t*)(ws + OFF_UF) };
    const float* GL = (const float*)(ws + OFF_GL);
    bf16_t* ODN = (bf16_t*)((unsigned char*)p.out + OUT_ODN);
    u32x4 pre[NB][5];
#pragma unroll
    for (int j = 0; j < NB; ++j) { const size_t un = (size_t)(bh0 + j) * 64;
#pragma unroll
      for (int k = 0; k < 5; ++k) pre[j][k] = *(const u32x4*)(src[k] + un * 4096 + tid * 8);
#pragma unroll
      for (int k = 0; k < 5; ++k) *(LAS u32x4*)(L + j * DNS_LDS + k * 8192 + tid * 16) = pre[j][k]; }
    __syncthreads();
    f32x16 S[2]; S[0] = zero16(); S[1] = zero16();
    for (int c = 0; c < 64; ++c) {
        u32x4 zr[NB];
#pragma unroll
        for (int j = 0; j < NB; ++j) { const int bh = bh0 + j, b = bh >> 3, h = bh & 7; const size_t un = (size_t)bh * 64 + c;
            if (c < 63) {
#pragma unroll
                for (int k = 0; k < 5; ++k) pre[j][k] = *(const u32x4*)(src[k] + (un + 1) * 4096 + tid * 8); }
            zr[j] = *(const u32x4*)(P + ((size_t)b * SEQ + c * 64 + (tid >> 3)) * NP + CZ + h * 64 + (tid & 7) * 8); }
        if (wave < 2 * NB) {
            const int sl = wave & 1, js = wave >> 1;
            LAS unsigned char* B = L + js * DNS_LDS; LAS float* ot = (LAS float*)(B + 40960);
            LAS unsigned char* Wt = B; LAS unsigned char* Kt = B + 8192; LAS unsigned char* Qt = B + 16384; LAS unsigned char* At = B + 24576; LAS unsigned char* Ut = B + 32768;
            bf16x8 Sb[4]; Sb[0] = pack8(S[0], 0); Sb[1] = pack8(S[0], 1); Sb[2] = pack8(S[1], 0); Sb[3] = pack8(S[1], 1);
            f32x16 T1[2]; T1[0] = zero16(); T1[1] = zero16();
#pragma unroll
            for (int rt = 0; rt < 2; ++rt)
#pragma unroll
                for (int sp = 0; sp < 4; ++sp) T1[rt] = MFMA32(*(const LAS bf16x8*)(Wt + ((rt * 4 + sp) * 64 + lane) * 16), Sb[sp], T1[rt]);
            f32x16 vn[2];
#pragma unroll
            for (int rt = 0; rt < 2; ++rt) { const u32x4 ua = *(const LAS u32x4*)(Ut + ((sl * 2 + rt) * 64 + lane) * 32), ub = *(const LAS u32x4*)(Ut + ((sl * 2 + rt) * 64 + lane) * 32 + 16);
                vn[rt][0] = blo(ua.x) - T1[rt][0]; vn[rt][1] = bhi(ua.x) - T1[rt][1]; vn[rt][2] = blo(ua.y) - T1[rt][2]; vn[rt][3] = bhi(ua.y) - T1[rt][3];
                vn[rt][4] = blo(ua.z) - T1[rt][4]; vn[rt][5] = bhi(ua.z) - T1[rt][5]; vn[rt][6] = blo(ua.w) - T1[rt][6]; vn[rt][7] = bhi(ua.w) - T1[rt][7];
                vn[rt][8] = blo(ub.x) - T1[rt][8]; vn[rt][9] = bhi(ub.x) - T1[rt][9]; vn[rt][10] = blo(ub.y) - T1[rt][10]; vn[rt][11] = bhi(ub.y) - T1[rt][11];
                vn[rt][12] = blo(ub.z) - T1[rt][12]; vn[rt][13] = bhi(ub.z) - T1[rt][13]; vn[rt][14] = blo(ub.w) - T1[rt][14]; vn[rt][15] = bhi(ub.w) - T1[rt][15]; }
            bf16x8 Vb[4]; Vb[0] = pack8(vn[0], 0); Vb[1] = pack8(vn[0], 1); Vb[2] = pack8(vn[1], 0); Vb[3] = pack8(vn[1], 1);
            f32x16 O[2]; O[0] = zero16(); O[1] = zero16();
#pragma unroll
            for (int rt = 0; rt < 2; ++rt)
#pragma unroll
                for (int sp = 0; sp < 4; ++sp) { O[rt] = MFMA32(*(const LAS bf16x8*)(Qt + ((rt * 4 + sp) * 64 + lane) * 16), Sb[sp], O[rt]);
                                                 O[rt] = MFMA32(*(const LAS bf16x8*)(At + ((rt * 4 + sp) * 64 + lane) * 16), Vb[sp], O[rt]); }
            const float gl = GL[(size_t)(bh0 + js) * 64 + c];
#pragma unroll
            for (int rt = 0; rt < 2; ++rt) {
#pragma unroll
                for (int r = 0; r < 16; ++r) S[rt][r] *= gl;
#pragma unroll
                for (int sp = 0; sp < 4; ++sp) S[rt] = MFMA32(*(const LAS bf16x8*)(Kt + ((rt * 4 + sp) * 64 + lane) * 16), Vb[sp], S[rt]); }
#pragma unroll
            for (int rt = 0; rt < 2; ++rt)
#pragma unroll
                for (int r = 0; r < 16; ++r) ot[(32 * rt + crow(r, hh)) * 65 + 32 * sl + l31] = O[rt][r];
        }
        __syncthreads();
#pragma unroll
        for (int j = 0; j < NB; ++j) { const int bh = bh0 + j, b = bh >> 3, h = bh & 7;
            if (c < 63) {
#pragma unroll
                for (int k = 0; k < 5; ++k) *(LAS u32x4*)(L + j * DNS_LDS + k * 8192 + tid * 16) = pre[j][k]; }
            LAS float* ot = (LAS float*)(L + j * DNS_LDS + 40960);
            const int t = tid >> 3, part = tid & 7; float o8[8]; float ss = 0.f;
#pragma unroll
            for (int q = 0; q < 8; ++q) { o8[q] = ot[t * 65 + part * 8 + q]; ss += o8[q] * o8[q]; }
            ss += __shfl_xor(ss, 1); ss += __shfl_xor(ss, 2); ss += __shfl_xor(ss, 4);
            const float rstd = rsqrtf(ss * (1.0f / 64.0f) + 1e-6f);
            const size_t tok = (size_t)b * SEQ + c * 64 + t;
            const float* ng = p.in[16] + part * 8;
            const u32x4 z = zr[j];
            float z8[8]; z8[0] = blo(z.x); z8[1] = bhi(z.x); z8[2] = blo(z.y); z8[3] = bhi(z.y); z8[4] = blo(z.z); z8[5] = bhi(z.z); z8[6] = blo(z.w); z8[7] = bhi(z.w);
            float y8[8];
#pragma unroll
            for (int q = 0; q < 8; ++q) y8[q] = o8[q] * rstd * ng[q] * siluf(z8[q]);
            u32x4 w; w.x = pack2(y8[0], y8[1]); w.y = pack2(y8[2], y8[3]); w.z = pack2(y8[4], y8[5]); w.w = pack2(y8[6], y8[7]);
            *(u32x4*)(ODN + tok * 512 + h * 64 + part * 8) = w; }
        __syncthreads();
    }
}
DI void compress_task(const Params& p, LAS unsigned char* L, int task) {
    const int tid = threadIdx.x, w = tid >> 6, lane = tid & 63, l31 = lane & 31, hh = lane >> 5;
    unsigned char* ws = p.ws;
    const int which = task >> 7, rem = task & 127, b = rem >> 4, kvh = (rem >> 3) & 1, nt = rem & 7;
    const bf16_t* P = (const bf16_t*)(ws + OFF_P);
    const bf16_t* W1T = (const bf16_t*)(ws + (which ? OFF_W1V : OFF_W1K)); const bf16_t* W2T = (const bf16_t*)(ws + (which ? OFF_W2V : OFF_W2K));
    const int col = (which ? CVC : CKC) + kvh * 64, n = nt * 32 + l31, nc = n < 254 ? n : 254;
    f32x16 acc[2]; acc[0] = zero16(); acc[1] = zero16();
#pragma unroll 4
    for (int ksl = 0; ksl < 16; ++ksl) { const int ks = 16 * w + ksl, ltok = ks >> 2, d0 = (ks & 3) * 16 + 8 * hh;
        const bf16x8 bfr = *(const bf16x8*)(P + ((size_t)b * SEQ + 16 * nc + ltok) * NP + col + d0);
#pragma unroll
        for (int rt = 0; rt < 2; ++rt) { const bf16x8 a = *(const bf16x8*)(W1T + (size_t)(32 * rt + l31) * 2048 + 16 * ks + 8 * hh); acc[rt] = MFMA32(a, bfr, acc[rt]); } }
    LAS float* red = (LAS float*)L;
#pragma unroll
    for (int rt = 0; rt < 2; ++rt)
#pragma unroll
        for (int r = 0; r < 16; ++r) red[((w * 2 + rt) * 16 + r) * 64 + lane] = acc[rt][r];
    __syncthreads();
    if (w == 0) {
        const float* c1 = (const float*)(ws + OFF_C1) + which * 64;
        f32x16 G[2];
#pragma unroll
        for (int rt = 0; rt < 2; ++rt)
#pragma unroll
            for (int r = 0; r < 16; ++r) { float s = c1[32 * rt + crow(r, hh)];
#pragma unroll
                for (int w2 = 0; w2 < 8; ++w2) s += red[((w2 * 2 + rt) * 16 + r) * 64 + lane];
                G[rt][r] = gelu_tanh(s); }
        bf16x8 Hb[4]; Hb[0] = pack8(G[0], 0); Hb[1] = pack8(G[0], 1); Hb[2] = pack8(G[1], 0); Hb[3] = pack8(G[1], 1);
        bf16_t* KC = (bf16_t*)(ws + OFF_KC); bf16_t* VCT = (bf16_t*)(ws + OFF_VCT);
#pragma unroll
        for (int ot = 0; ot < 2; ++ot) { f32x16 o = zero16(); const int row = 32 * ot + l31;
#pragma unroll
            for (int sp = 0; sp < 4; ++sp) { const u32x2 lo = *(const u32x2*)(W2T + row * 64 + 16 * sp + 4 * hh), hi = *(const u32x2*)(W2T + row * 64 + 16 * sp + 8 + 4 * hh);
                u32x4 aw; aw.x = lo.x; aw.y = lo.y; aw.z = hi.x; aw.w = hi.y; o = MFMA32(__builtin_bit_cast(bf16x8, aw), Hb[sp], o); }
            if (which == 0) {
#pragma unroll
                for (int a = 0; a < 4; ++a) { u32x2 wv; wv.x = pack2(o[4 * a], o[4 * a + 1]); wv.y = pack2(o[4 * a + 2], o[4 * a + 3]);
                    *(u32x2*)(KC + ((size_t)((b * 2 + kvh) * 256 + n)) * 64 + 32 * ot + 8 * a + 4 * hh) = wv; }
            } else {
#pragma unroll
                for (int r = 0; r < 16; ++r) VCT[((size_t)((b * 2 + kvh) * 64 + 32 * ot + crow(r, hh))) * 256 + (n & ~15) + vperm16(n & 15)] = f2bf(o[r]);
            }
        }
    }
    __syncthreads();
}
DI void vtrans_unit(const Params& p, LAS unsigned char* L, int unit0) {
    const int tid = threadIdx.x;
    unsigned char* ws = p.ws;
    const bf16_t* P = (const bf16_t*)(ws + OFF_P);
    { const int tok = tid >> 3, ch = tid & 7; u32x4 v[4];
#pragma unroll
      for (int q = 0; q < 4; ++q) { const int unit = unit0 + q, which = unit >> 10, rem = unit & 1023, b = rem >> 7, kvh = (rem >> 6) & 1, blk = rem & 63;
          v[q] = *(const u32x4*)(P + ((size_t)b * SEQ + blk * 64 + tok) * NP + (which ? CVW : CVS) + kvh * 64 + ch * 8); }
#pragma unroll
      for (int q = 0; q < 4; ++q) *(LAS u32x4*)((LAS bf16_t*)(L + q * 9216) + tok * 72 + ch * 8) = v[q]; }
    __syncthreads();
    { const int d = tid >> 3, ch = tid & 7, grp = ch >> 1, hq = ch & 1;
#pragma unroll
      for (int q = 0; q < 4; ++q) { const int unit = unit0 + q, which = unit >> 10, rem = unit & 1023, b = rem >> 7, kvh = (rem >> 6) & 1, blk = rem & 63;
          LAS bf16_t* tile = (LAS bf16_t*)(L + q * 9216); bf16_t e8[8];
#pragma unroll
          for (int e = 0; e < 8; ++e) e8[e] = tile[(16 * grp + 8 * (e >> 2) + 4 * hq + (e & 3)) * 72 + d];
          u32x4 w; w.x = (unsigned)e8[0] | ((unsigned)e8[1] << 16); w.y = (unsigned)e8[2] | ((unsigned)e8[3] << 16); w.z = (unsigned)e8[4] | ((unsigned)e8[5] << 16); w.w = (unsigned)e8[6] | ((unsigned)e8[7] << 16);
          bf16_t* VT = (bf16_t*)(ws + (which ? OFF_VTW : OFF_VTS));
          *(u32x4*)(VT + ((size_t)((b * 2 + kvh) * 64 + d)) * SEQ + blk * 64 + ch * 8) = w; } }
    __syncthreads();
}
constexpr int AT_K = 0, AT_V = 18432, AT_IMP = 36864, AT_BT = 53504, AT_SEL = 55552, AT_TL = 56064, AT_OACC = 63488, AT_Q = 96256;
struct AttnCtx { int i, g, th, l31, hh, lane, tid, tq; };
DI float xhalf_max(float v) {
    const auto r = __builtin_amdgcn_permlane32_swap(__float_as_uint(v), __float_as_uint(v), false, false); return fmaxf(__uint_as_float(r[0]), __uint_as_float(r[1])); }
template <int BR, int MODE>
DI void attn_tiles(LAS unsigned char* L, const AttnCtx& cx, const bf16_t* Kbase, size_t kpitch, const bf16_t* VTbase, size_t vpitch, int ntiles, int id0,
                   const LAS unsigned char* Ql, float& m, float& l, f32x16 (&O)[2]) {
    if (ntiles <= 0) return;
    const int tid = cx.tid, l31 = cx.l31, hh = cx.hh;
    LAS int* tl = (LAS int*)(L + AT_TL); LAS float* bt = (LAS float*)(L + AT_BT) + cx.g * 128; LAS float* imp = (LAS float*)(L + AT_IMP); LAS unsigned* selm = (LAS unsigned*)(L + AT_SEL);
    int srow = tid >> 3; const int sch = tid & 7; asm volatile("" : "+v"(srow));
    constexpr float QS = 0.125f * 1.4426950408889634f;
    u32x4 kreg, vreg;
    { const int id = (BR == 1) ? tl[1] : id0;
      kreg = *(const u32x4*)(Kbase + (size_t)(id * 64 + srow) * kpitch + sch * 8);
      if (MODE == 0) vreg = *(const u32x4*)(VTbase + (size_t)srow * vpitch + id * 64 + sch * 8);
      *(LAS u32x4*)(L + AT_K + srow * 144 + sch * 16) = kreg;
      if (MODE == 0) *(LAS u32x4*)(L + AT_V + srow * 144 + sch * 16) = vreg; }
    __syncthreads();
    const float inv = (MODE == 1) ? (l > 0.f ? 1.0f / l : 0.f) : 0.f;
    const float bconst = bt[127];
    for (int k = 0; k < ntiles; ++k) {
        const int buf = k & 1;
        const int id = (BR == 1) ? tl[1 + k] : id0 + k;
        LAS unsigned char* Kt = L + AT_K + buf * 9216; LAS unsigned char* Vt = L + AT_V + buf * 9216;
        const int lastpos = (BR == 0) ? (16 * (id * 64 + 63) + 31) : (id * 64 + 63);
        const bool cbias = (64 * cx.i - lastpos) >= 127;
        const bool edge = (MODE == 1) ? true : (BR == 0) ? (lastpos > 64 * cx.i) : (BR == 1) ? (id == cx.i) : (id == cx.i || id == cx.i - 8);
        bool sel = true;
        if (BR == 1) sel = ((selm[(32 * cx.th + l31) * 2 + (id >> 5)] >> (id & 31)) & 1u) != 0u;
        f32x16 S0 = zero16(), S1 = zero16();
#pragma unroll
        for (int s = 0; s < 4; ++s) { const bf16x8 qf = *(const LAS bf16x8*)(Ql + 32 * s);
                                      S0 = MFMA32(*(const LAS bf16x8*)(Kt + l31 * 144 + (16 * s + 8 * hh) * 2), qf, S0);
                                      S1 = MFMA32(*(const LAS bf16x8*)(Kt + (32 + l31) * 144 + (16 * s + 8 * hh) * 2), qf, S1); }
#if (MK_REP >> 27) & 1
        { f32x16 T0 = zero16(), T1 = zero16();
#pragma unroll
          for (int s = 0; s < 4; ++s) { bf16x8 qf = *(const LAS bf16x8*)(Ql + 32 * s); asm volatile("" : "+v"(qf));
              T0 = MFMA32(*(const LAS bf16x8*)(Kt + l31 * 144 + (16 * s + 8 * hh) * 2), qf, T0); T1 = MFMA32(*(const LAS bf16x8*)(Kt + (32 + l31) * 144 + (16 * s + 8 * hh) * 2), qf, T1); }
          asm volatile("" :: "v"(T0[0] + T0[7] + T1[3] + T1[15])); }
#endif
        asm volatile("" ::: "memory");
        if (k + 1 < ntiles) { const int idn = (BR == 1) ? tl[2 + k] : id0 + k + 1;
            kreg = *(const u32x4*)(Kbase + (size_t)(idn * 64 + srow) * kpitch + sch * 8);
            if (MODE == 0) vreg = *(const u32x4*)(VTbase + (size_t)srow * vpitch + idn * 64 + sch * 8); }
        const int kb0 = id * 64 + 4 * hh;
        if (MODE == 0 && cbias && !edge) {
            float mx = fmaxf(S0[0], S1[0]);
#pragma unroll
            for (int r = 1; r < 16; ++r) mx = fmaxf(fmaxf(mx, S0[r]), S1[r]);
            mx = mx * QS + bconst;
            if (BR == 1) mx = sel ? mx : -1e30f;
            mx = xhalf_max(mx);
            const float mn = fmaxf(m, mx);
            { const float alpha = __builtin_amdgcn_exp2f(m - mn); l *= alpha;
#pragma unroll
                for (int r = 0; r < 16; ++r) { O[0][r] *= alpha; O[1][r] *= alpha; } }
            m = mn;
            const float c0 = bconst - (((mn <= -1e29f) || !sel) ? 3.0e38f : mn);
            float rs = 0.f;
#pragma unroll
            for (int r = 0; r < 16; ++r) { S0[r] = __builtin_amdgcn_exp2f(__builtin_fmaf(S0[r], QS, c0)); S1[r] = __builtin_amdgcn_exp2f(__builtin_fmaf(S1[r], QS, c0)); rs += S0[r] + S1[r]; }
            l += rs;
#if (MK_REP >> 28) & 1
            { float dd = 0.f;
#pragma unroll
              for (int r = 0; r < 16; ++r) { float a = S0[r], b = S1[r]; asm volatile("" : "+v"(a), "+v"(b)); dd += __builtin_amdgcn_exp2f(__builtin_fmaf(a, QS, c0)) + __builtin_amdgcn_exp2f(__builtin_fmaf(b, QS, c0)); }
              asm volatile("" :: "v"(dd)); }
#endif
        } else {
        if (cbias) {
#pragma unroll
            for (int r = 0; r < 16; ++r) { S0[r] = __builtin_fmaf(S0[r], QS, bconst); S1[r] = __builtin_fmaf(S1[r], QS, bconst); }
        } else {
#pragma unroll
            for (int r = 0; r < 16; ++r) { const int k0i = kb0 + 8 * (r >> 2) + (r & 3), k1i = k0i + 32;
                int d0 = (BR == 0) ? (cx.tq - (16 * k0i + 31)) : (cx.tq - k0i), d1 = (BR == 0) ? (cx.tq - (16 * k1i + 31)) : (cx.tq - k1i);
                d0 = d0 < 0 ? 0 : (d0 > 127 ? 127 : d0); d1 = d1 < 0 ? 0 : (d1 > 127 ? 127 : d1);
                S0[r] = __builtin_fmaf(S0[r], QS, bt[d0]); S1[r] = __builtin_fmaf(S1[r], QS, bt[d1]); }
        }
        if (edge) {
#pragma unroll
            for (int r = 0; r < 16; ++r) { const int k0i = kb0 + 8 * (r >> 2) + (r & 3), k1i = k0i + 32;
                const int d0 = (BR == 0) ? (cx.tq - (16 * k0i + 31)) : (cx.tq - k0i), d1 = (BR == 0) ? (cx.tq - (16 * k1i + 31)) : (cx.tq - k1i);
                bool v0 = d0 >= 0, v1 = d1 >= 0; if (BR == 2) { v0 = v0 && (d0 < 512); v1 = v1 && (d1 < 512); }
                S0[r] = v0 ? S0[r] : -1e30f; S1[r] = v1 ? S1[r] : -1e30f; }
        }
        if (MODE == 0) {
            float mx = -1e30f;
#pragma unroll
            for (int r = 0; r < 16; ++r) mx = fmaxf(fmaxf(mx, S0[r]), S1[r]);
            if (BR == 1) mx = sel ? mx : -1e30f;
            mx = xhalf_max(mx);
            const float mn = fmaxf(m, mx);
            { const float alpha = __builtin_amdgcn_exp2f(m - mn); l *= alpha;
#pragma unroll
                for (int r = 0; r < 16; ++r) { O[0][r] *= alpha; O[1][r] *= alpha; } }
            m = mn;
            const float mref = ((mn <= -1e29f) || !sel) ? 3.0e38f : mn;
            float rs = 0.f;
#pragma unroll
            for (int r = 0; r < 16; ++r) { S0[r] = __builtin_amdgcn_exp2f(S0[r] - mref); S1[r] = __builtin_amdgcn_exp2f(S1[r] - mref); rs += S0[r] + S1[r]; }
            l += rs;
        } }
        if (MODE == 0) {
            asm volatile("" ::: "memory");
            const bf16x8 P00 = pack8(S0, 0), P01 = pack8(S0, 1), P10 = pack8(S1, 0), P11 = pack8(S1, 1);
#pragma unroll
            for (int dt = 0; dt < 2; ++dt) {
                O[dt] = MFMA32(*(const LAS bf16x8*)(Vt + (32 * dt + l31) * 144 + (8 * hh) * 2), P00, O[dt]);
                O[dt] = MFMA32(*(const LAS bf16x8*)(Vt + (32 * dt + l31) * 144 + (16 + 8 * hh) * 2), P01, O[dt]);
                O[dt] = MFMA32(*(const LAS bf16x8*)(Vt + (32 * dt + l31) * 144 + (32 + 8 * hh) * 2), P10, O[dt]);
                O[dt] = MFMA32(*(const LAS bf16x8*)(Vt + (32 * dt + l31) * 144 + (48 + 8 * hh) * 2), P11, O[dt]); }
        } else {
            const float mref = (m <= -1e29f) ? 3.0e38f : m;
#pragma unroll
            for (int kt = 0; kt < 2; ++kt)
#pragma unroll
                for (int a = 0; a < 4; ++a) { float s4 = 0.f, p3 = 0.f;
#pragma unroll
                    for (int b2 = 0; b2 < 4; ++b2) { const int r = 4 * a + b2; const float pv = __builtin_amdgcn_exp2f((kt ? S1[r] : S0[r]) - mref) * inv; s4 += pv; if (b2 == 3) p3 = pv; }
                    const int jblk = 16 * id + 8 * kt + 2 * a + hh;
                    LAS float* ip = imp + (32 * cx.th + l31) * 65 + jblk;
                    __hip_atomic_fetch_add(ip, s4, __ATOMIC_RELAXED, __HIP_MEMORY_SCOPE_WORKGROUP);
                    if (jblk + 1 < 64) __hip_atomic_fetch_add(ip + 1, p3, __ATOMIC_RELAXED, __HIP_MEMORY_SCOPE_WORKGROUP); }
        }
        if (k + 1 < ntiles) { *(LAS u32x4*)(L + AT_K + ((k + 1) & 1) * 9216 + srow * 144 + sch * 16) = kreg;
            if (MODE == 0) *(LAS u32x4*)(L + AT_V + ((k + 1) & 1) * 9216 + srow * 144 + sch * 16) = vreg; }
        __syncthreads();
    }
    if (MODE == 0) l += __shfl_xor(l, 32);
}
DI void attn_unit(const Params& p, LAS unsigned char* L, int unit) {
    AttnCtx cx; cx.tid = threadIdx.x; const int wave = cx.tid >> 6; cx.lane = cx.tid & 63; cx.l31 = cx.lane & 31; cx.hh = cx.lane >> 5; cx.g = wave >> 1; cx.th = wave & 1;
    unsigned char* ws = p.ws;
    const int i = 63 - (unit >> 4), bk = unit & 15, b = bk >> 1, kvh = bk & 1, hq = kvh * 4 + cx.g;
    cx.i = i; cx.tq = 64 * i + 32 * cx.th + cx.l31;
    const bf16_t* P = (const bf16_t*)(ws + OFF_P);
    const size_t tokq = (size_t)b * SEQ + cx.tq;
    LAS float* imp = (LAS float*)(L + AT_IMP); LAS unsigned* selm = (LAS unsigned*)(L + AT_SEL); LAS int* tl = (LAS int*)(L + AT_TL);
    LAS unsigned char* Qf = L + AT_Q + (wave * 32 + cx.l31) * 144 + 16 * cx.hh;
#pragma unroll
    for (int s = 0; s < 4; ++s) *(LAS bf16x8*)(Qf + 32 * s) = *(const bf16x8*)(P + tokq * NP + CQ + hq * 64 + 16 * s + 8 * cx.hh);
    LAS float* gts = (LAS float*)(L + AT_TL + 320) + (wave * 64 + cx.lane) * 3;
    if (cx.hh == 0 || true) { gts[0] = sigmf(bf2f(P[tokq * NP + CNG + hq * 3 + 0])); gts[1] = sigmf(bf2f(P[tokq * NP + CNG + hq * 3 + 1])); gts[2] = sigmf(bf2f(P[tokq * NP + CNG + hq * 3 + 2])); }
    ((LAS float*)(L + AT_BT))[cx.tid] = ((const float*)(ws + OFF_BTAB))[kvh * 512 + cx.tid] * 1.4426950408889634f;
    for (int q = cx.tid; q < 64 * 65; q += 512) imp[q] = 0.f;
    if (cx.tid < 128) selm[cx.tid] = 0u;
    __syncthreads();
    LAS bf16_t* oab = (LAS bf16_t*)(L + AT_OACC) + (wave * 32) * 64 + cx.lane;
    { const bf16_t* KC = (const bf16_t*)(ws + OFF_KC) + (size_t)((b * 2 + kvh) * 256) * 64; const bf16_t* VCT = (const bf16_t*)(ws + OFF_VCT) + (size_t)((b * 2 + kvh) * 64) * 256;
      const int nt = ((4 * i + 2) >> 6) + 1;
      float m = -1e30f, l = 0.f; f32x16 O[2]; O[0] = zero16(); O[1] = zero16();
      attn_tiles<0, 0>(L, cx, KC, 64, VCT, 256, nt, 0, Qf, m, l, O);
      const float sc0 = l > 0.f ? gts[0] / l : 0.f;
#pragma unroll
      for (int r = 0; r < 16; ++r) { oab[r * 64] = f2bf(O[0][r] * sc0); oab[(16 + r) * 64] = f2bf(O[1][r] * sc0); }
#if (MK_REP >> 18) & 1
      { float m2 = -1e30f, l2 = 0.f; f32x16 O2[2]; O2[0] = zero16(); O2[1] = zero16(); attn_tiles<0, 0>(L, cx, KC, 64, VCT, 256, nt, 0, Qf, m2, l2, O2); asm volatile("" :: "v"(O2[0][0] + O2[1][5] + l2 + m2)); }
#endif
      attn_tiles<0, 1>(L, cx, KC, 64, VCT, 256, nt, 0, Qf, m, l, O);
    }
    __syncthreads();
    { const int q = cx.tid & 63, w8 = cx.tid >> 6; unsigned myk[8]; int cnt[8];
      LAS unsigned* impk = (LAS unsigned*)imp;
#pragma unroll
      for (int jj = 0; jj < 8; ++jj) { const int j = 8 * w8 + jj; const float v = imp[q * 65 + j] + ((j == 0 || j == i || j == i - 1) ? 1.0e4f : 0.f);
          myk[jj] = (__float_as_uint(v) & ~63u) | (unsigned)(63 - j); cnt[jj] = 0; }
#pragma unroll
      for (int jj = 0; jj < 8; ++jj) impk[q * 65 + 8 * w8 + jj] = myk[jj];
      __syncthreads();
      for (int j2 = 0; j2 <= i; ++j2) { const unsigned k2 = impk[q * 65 + j2];
#pragma unroll
          for (int jj = 0; jj < 8; ++jj) cnt[jj] += (k2 > myk[jj]) ? 1 : 0; }
      unsigned bits = 0u;
#pragma unroll
      for (int jj = 0; jj < 8; ++jj) { const int j = 8 * w8 + jj; if (j <= i && cnt[jj] < 16) bits |= 1u << jj; }
      __hip_atomic_fetch_or(selm + q * 2 + (w8 >> 2), bits << ((w8 & 3) * 8), __ATOMIC_RELAXED, __HIP_MEMORY_SCOPE_WORKGROUP);
    }
    __syncthreads();
    if (wave == 0) { unsigned u0 = selm[cx.lane * 2], u1 = selm[cx.lane * 2 + 1];
#pragma unroll
        for (int o = 32; o >= 1; o >>= 1) { u0 |= __shfl_xor(u0, o); u1 |= __shfl_xor(u1, o); }
        { const unsigned long long um = ((unsigned long long)u1 << 32) | u0;
          const int j = cx.lane; const bool on = (j <= i) && ((um >> j) & 1ull);
          if (on) tl[1 + __popcll(um & ((1ull << j) - 1ull))] = j;
          if (j == 0) tl[0] = __popcll(i >= 63 ? um : (um & ((1ull << (i + 1)) - 1ull))); } }
    __syncthreads();
    { const bf16_t* KS = P + ((size_t)b * SEQ) * NP + CKS + kvh * 64; const bf16_t* VTS = (const bf16_t*)(ws + OFF_VTS) + (size_t)((b * 2 + kvh) * 64) * SEQ;
      const int nt = tl[0];
      float m = -1e30f, l = 0.f; f32x16 O[2]; O[0] = zero16(); O[1] = zero16();
      attn_tiles<1, 0>(L, cx, KS, NP, VTS, SEQ, nt, 0, Qf, m, l, O);
      const float sc1 = l > 0.f ? gts[1] / l : 0.f;
#pragma unroll
      for (int r = 0; r < 16; ++r) { oab[r * 64] = f2bf(bf2f(oab[r * 64]) + O[0][r] * sc1); oab[(16 + r) * 64] = f2bf(bf2f(oab[(16 + r) * 64]) + O[1][r] * sc1); }
#if (MK_REP >> 19) & 1
      { float m2 = -1e30f, l2 = 0.f; f32x16 O2[2]; O2[0] = zero16(); O2[1] = zero16(); attn_tiles<1, 0>(L, cx, KS, NP, VTS, SEQ, nt, 0, Qf, m2, l2, O2); asm volatile("" :: "v"(O2[0][0] + O2[1][5] + l2 + m2)); }
#endif
    }
    { const bf16_t* KW = P + ((size_t)b * SEQ) * NP + CKW + kvh * 64; const bf16_t* VTW = (const bf16_t*)(ws + OFF_VTW) + (size_t)((b * 2 + kvh) * 64) * SEQ;
      const int j0 = i > 8 ? i - 8 : 0;
      float m = -1e30f, l = 0.f; f32x16 O[2]; O[0] = zero16(); O[1] = zero16();
      attn_tiles<2, 0>(L, cx, KW, NP, VTW, SEQ, i - j0 + 1, j0, Qf, m, l, O);
      const float sc2 = l > 0.f ? gts[2] / l : 0.f;
      bf16_t* ONSA = (bf16_t*)((unsigned char*)p.out + OUT_ONSA);
#pragma unroll
      for (int dt = 0; dt < 2; ++dt)
#pragma unroll
        for (int a = 0; a < 4; ++a) { float o4[4];
#pragma unroll
            for (int j = 0; j < 4; ++j) o4[j] = bf2f(oab[(16 * dt + 4 * a + j) * 64]) + O[dt][4 * a + j] * sc2;
            u32x2 wv; wv.x = pack2(o4[0], o4[1]); wv.y = pack2(o4[2], o4[3]);
            *(u32x2*)(ONSA + tokq * 512 + hq * 64 + 32 * dt + 8 * a + 4 * cx.hh) = wv; }
#if (MK_REP >> 20) & 1
      { float m2 = -1e30f, l2 = 0.f; f32x16 O2[2]; O2[0] = zero16(); O2[1] = zero16(); attn_tiles<2, 0>(L, cx, KW, NP, VTW, SEQ, i - j0 + 1, j0, Qf, m2, l2, O2); asm volatile("" :: "v"(O2[0][0] + O2[1][5] + l2 + m2)); }
#endif
    }
    __syncthreads();
}
template <int N> DI int dpp_rori(int v) { return __builtin_amdgcn_update_dpp(0, v, 0x120 + N, 0xF, 0xF, false); }
template <int N> DI float dpp_ror(float v) { return __uint_as_float((unsigned)__builtin_amdgcn_update_dpp(0, (int)__float_as_uint(v), 0x120 + N, 0xF, 0xF, false)); }
DI unsigned f2ord(float f) { const unsigned b = __float_as_uint(f); return (b & 0x80000000u) ? ~b : (b | 0x80000000u); }
DI float ord2f(unsigned u) { return __uint_as_float((u & 0x80000000u) ? (u & 0x7FFFFFFFu) : ~u); }
DI unsigned umax(unsigned a, unsigned b) { return a > b ? a : b; }
DI unsigned umin(unsigned a, unsigned b) { return a < b ? a : b; }
DI void ins16(unsigned (&t)[16], unsigned x) {
#pragma unroll
    for (int i = 0; i < 16; ++i) { const unsigned hi = umax(t[i], x); x = umin(t[i], x); t[i] = hi; } }
DI unsigned sel16(const unsigned (&v)[16], int i) { unsigned r = v[0];
#pragma unroll
    for (int j = 1; j < 16; ++j) { r = (i == j) ? v[j] : r; asm volatile("" : "+v"(r)); } return r; }
constexpr unsigned char BS_A[80] = {0,3,4,7,8,11,12,15,0,1,6,7,8,9,14,15,0,2,5,7,8,10,13,15,0,1,2,3,12,13,14,15,0,1,4,5,10,11,14,15,0,2,4,6,9,11,13,15,0,1,2,3,4,5,6,7,0,1,2,3,8,9,10,11,0,1,4,5,8,9,12,13,0,2,4,6,8,10,12,14};
constexpr unsigned char BS_B[80] = {1,2,5,6,9,10,13,14,2,3,4,5,10,11,12,13,1,3,4,6,9,11,12,14,4,5,6,7,8,9,10,11,2,3,6,7,8,9,12,13,1,3,5,7,8,10,12,14,8,9,10,11,12,13,14,15,4,5,6,7,12,13,14,15,2,3,6,7,10,11,14,15,1,3,5,7,9,11,13,15};
DI void sort16(unsigned (&v)[16]) {
#pragma unroll
    for (int n = 0; n < 80; ++n) { const unsigned hi = umax(v[BS_A[n]], v[BS_B[n]]), lo = umin(v[BS_A[n]], v[BS_B[n]]); v[BS_A[n]] = hi; v[BS_B[n]] = lo; } }
DI void bmerge16(unsigned (&v)[16]) {
#pragma unroll
    for (int n = 48; n < 80; ++n) { const unsigned hi = umax(v[BS_A[n]], v[BS_B[n]]), lo = umin(v[BS_A[n]], v[BS_B[n]]); v[BS_A[n]] = hi; v[BS_B[n]] = lo; } }
DI void route_half(const bf16_t* QRY, const bf16_t* KEYS, size_t tok, int hd, int half, int l31, int hh, unsigned (&top)[16]) {
    bf16x8 qf[4];
#pragma unroll
    for (int s = 0; s < 4; ++s) qf[s] = *(const bf16x8*)(QRY + tok * 1024 + hd * 128 + half * 64 + 16 * s + 8 * hh);
#pragma unroll
    for (int k = 0; k < 16; ++k) top[k] = 0u;
    const bf16_t* kp = KEYS + (size_t)(((half * 8 + hd) * 128) + l31) * 64 + 8 * hh;
#pragma unroll 2
    for (int kt = 0; kt < 4; ++kt) { f32x16 D = zero16();
        bf16x8 ac[4];
#pragma unroll
        for (int s = 0; s < 4; ++s) ac[s] = *(const bf16x8*)(kp + (size_t)(32 * kt) * 64 + 16 * s);
        __builtin_amdgcn_s_setprio(1);
#pragma unroll
        for (int s = 0; s < 4; ++s) D = MFMA32(ac[s], qf[s], D);
        __builtin_amdgcn_s_setprio(0);
        unsigned u[16];
#pragma unroll
        for (int r = 0; r < 16; ++r) { const int key = 32 * kt + crow(r, hh); u[r] = (f2ord(D[r]) & ~0x7Fu) | (unsigned)(127 - key); }
        sort16(u);
#pragma unroll
        for (int k = 0; k < 16; ++k) top[k] = umax(top[k], u[15 - k]);
        bmerge16(top); }
    unsigned cc[16];
#pragma unroll
    for (int k = 0; k < 16; ++k) cc[k] = (unsigned)__shfl_xor((int)top[k], 32);
#pragma unroll
    for (int k = 0; k < 16; ++k) top[k] = umax(top[k], cc[15 - k]);
    bmerge16(top);
}
#ifndef PE_AUX
#define PE_AUX 0
#endif
#ifndef GS_LOG
#define GS_LOG 2
#endif
constexpr int GSZ = 1 << GS_LOG, GSM = GSZ - 1;
constexpr int PSL_LOG = 4, PSL = 1 << PSL_LOG, PSL_SH = 14 - PSL_LOG;
constexpr int TPW = 8;
constexpr int PS_GRP = 256;
constexpr int PS_RIDX = 0, PS_RGATE = 16384, PS_SIDX = 32768, PS_SGS = PS_SIDX + 8 * PS_GRP * 8, PS_CNT = PS_SGS + 8 * PS_GRP * 16, PS_BASE = PS_CNT + 8 * 512, PS_GCNT = PS_BASE + 8 * 512, PS_KB = PS_GCNT + 8 * 512, PS_HQB = PS_KB + 8 * 64 * 32;
static_assert(PS_HQB + 8 * 4096 <= LDS_BYTES - LDS_USER, "PEER LDS layout");
DI int peer_dots(const u32x4 u0, const u32x4 u1, const u32x4 u2, const u32x4 u3, const u32x4 hqv) { const u32x4 nu[4] = {u0, u1, u2, u3};
    int d[4];
#pragma unroll
    for (int q = 0; q < 4; ++q) { int a = 0;
#pragma unroll
        for (int w = 0; w < 4; ++w) a = __builtin_amdgcn_sdot4((int)hqv[w], (int)nu[q][w], a, false);
        d[q] = a; }
    const auto pa = __builtin_amdgcn_permlane32_swap((unsigned)d[0], (unsigned)d[2], false, false); const unsigned k0 = pa[0] + pa[1];
    const auto pb = __builtin_amdgcn_permlane32_swap((unsigned)d[1], (unsigned)d[3], false, false); const unsigned k1 = pb[0] + pb[1];
    const auto pc = __builtin_amdgcn_permlane16_swap(k0, k1, false, false);
    return (int)(pc[0] + pc[1]);
}
DI int peer_rowsum(int kk) { kk += dpp_rori<8>(kk); kk += dpp_rori<4>(kk); kk += dpp_rori<2>(kk); kk += dpp_rori<1>(kk); return kk; }
DI float peer_gelu(const int kk, const unsigned mygs) {
    const float xg = (float)kk * bhi(mygs), ex = __builtin_amdgcn_exp2f(xg * __builtin_fmaf(xg * xg, -0.10294324f, -2.30220819f));
    return (blo(mygs) * xg) * __builtin_amdgcn_rcpf(1.0f + ex);
}
DI void peer_phase(const Params& p, LAS unsigned char* L, int bid, int nb) {
    const int tid = threadIdx.x, wave = __builtin_amdgcn_readfirstlane(tid >> 6);
    unsigned char* ws = p.ws;
    const bf16_t* QRY = (const bf16_t*)(ws + OFF_QRY); const bf16_t* KEYS = (const bf16_t*)(ws + OFF_KEYS); const bf16_t* H2 = (const bf16_t*)(ws + OFF_H2);
    const unsigned char* U8 = ws + OFF_UBF; const unsigned char* V8 = ws + OFF_VBF;
    const bf16_t* X1 = (const bf16_t*)(ws + OFF_X1); const float* mod = (const float*)(ws + OFF_MOD);
    LAS unsigned short* ridx = (LAS unsigned short*)(L + PS_RIDX); LAS bf16_t* rgate = (LAS bf16_t*)(L + PS_RGATE);
    LAS unsigned short* sidx = (LAS unsigned short*)(L + PS_SIDX) + wave * (PS_GRP * 4); LAS unsigned* sgs = (LAS unsigned*)(L + PS_SGS) + wave * (PS_GRP * 4);
    const float* USC = (const float*)(ws + OFF_USC);
    LAS int* cntl = (LAS int*)(L + PS_CNT) + wave * 128; LAS int* basel = (LAS int*)(L + PS_BASE) + wave * 128; LAS int* gcnt = (LAS int*)(L + PS_GCNT) + wave * 128;
    const int rot = (int)(((unsigned)PSL * xb_xcc_id() / 8u) & (unsigned)(PSL - 1));
    for (int tb = bid; tb < NTOK / (8 * TPW); tb += nb) {
        int lane = tid & 63; asm volatile("" : "+v"(lane));
        const int l31 = lane & 31, hh = lane >> 5;
#pragma unroll 1
        for (int task = wave; task < 2 * TPW; task += 8) { const int hd = task & 7, tt = task >> 3; const size_t tok = (size_t)tb * (8 * TPW) + tt * 32 + l31;
            unsigned v1[16], v2[16];
            route_half(QRY, KEYS, tok, hd, 0, l31, hh, v1);
            route_half(QRY, KEYS, tok, hd, 1, l31, hh, v2);
            unsigned t16[16];
#pragma unroll
            for (int k = 0; k < 16; ++k) t16[k] = 0u;
            { int cnt = 0; int pa1 = 0, pa2 = 0;
#pragma unroll
              for (int i1 = 0; i1 < 16; ++i1)
#pragma unroll
                for (int i2 = 0; i2 < 16; ++i2) if ((i1 + 1) * (i2 + 1) <= 16) {
                    if ((cnt & 1) == 0) { pa1 = i1; pa2 = i2; }
                    else { const float sa = ord2f(v1[pa1]) + ord2f(v2[pa2]), sb = ord2f(v1[i1]) + ord2f(v2[i2]);
                           const float sm = hh ? sb : sa; const unsigned ci = hh ? (unsigned)(255 - (i1 * 16 + i2)) : (unsigned)(255 - (pa1 * 16 + pa2));
                           ins16(t16, (f2ord(sm) & ~0xFFu) | ci); }
                    ++cnt; }
              unsigned cc[16];
#pragma unroll
              for (int k = 0; k < 16; ++k) cc[k] = (unsigned)__shfl_xor((int)t16[k], 32);
#pragma unroll
              for (int k = 0; k < 16; ++k) t16[k] = umax(t16[k], cc[15 - k]);
              bmerge16(t16); }
            const float mx = ord2f(t16[0]); float e[16]; float ssum = 0.f;
#pragma unroll
            for (int k = 0; k < 16; ++k) { e[k] = __expf(ord2f(t16[k]) - mx); ssum += e[k]; }
            const float rinv = __builtin_amdgcn_rcpf(ssum);
            { LAS unsigned char* kb = (LAS unsigned char*)(L + PS_KB) + (wave * 64 + lane) * 32;
#pragma unroll
              for (int w = 0; w < 4; ++w) { *(LAS unsigned*)(kb + 4 * w) = (v1[4 * w] & 0x7Fu) | ((v1[4 * w + 1] & 0x7Fu) << 8) | ((v1[4 * w + 2] & 0x7Fu) << 16) | ((v1[4 * w + 3] & 0x7Fu) << 24);
                                            *(LAS unsigned*)(kb + 16 + 4 * w) = (v2[4 * w] & 0x7Fu) | ((v2[4 * w + 1] & 0x7Fu) << 8) | ((v2[4 * w + 2] & 0x7Fu) << 16) | ((v2[4 * w + 3] & 0x7Fu) << 24); }
#pragma unroll
              for (int k = 0; k < 16; ++k) { const int ci = 255 - (int)(t16[k] & 0xFFu), i1 = ci >> 4, i2 = ci & 15;
                  const int k1 = 127 - (int)kb[i1], k2 = 127 - (int)kb[16 + i2];
                  if (hh == 0) { ridx[(tt * 32 + l31) * 128 + hd * 16 + k] = (unsigned short)(k1 * 128 + k2); rgate[(tt * 32 + l31) * 128 + hd * 16 + k] = f2bf(e[k] * rinv); } } }
        }
        __syncthreads();
        asm volatile("" : "+v"(lane));
        int hq[TPW][4]; float hsc[TPW];
#pragma unroll
        for (int j = 0; j < TPW; ++j) { const size_t tok = (size_t)tb * (8 * TPW) + TPW * wave + j; const u32x4 ha = *(const u32x4*)(H2 + tok * 1024 + lane * 16), hb = *(const u32x4*)(H2 + tok * 1024 + lane * 16 + 8);
            float hv[16]; hv[0] = blo(ha.x); hv[1] = bhi(ha.x); hv[2] = blo(ha.y); hv[3] = bhi(ha.y); hv[4] = blo(ha.z); hv[5] = bhi(ha.z); hv[6] = blo(ha.w); hv[7] = bhi(ha.w);
            hv[8] = blo(hb.x); hv[9] = bhi(hb.x); hv[10] = blo(hb.y); hv[11] = bhi(hb.y); hv[12] = blo(hb.z); hv[13] = bhi(hb.z); hv[14] = blo(hb.w); hv[15] = bhi(hb.w);
            float am = 0.f;
#pragma unroll
            for (int q = 0; q < 16; ++q) am = fmaxf(am, fabsf(hv[q]));
#pragma unroll
            for (int o = 32; o >= 1; o >>= 1) am = fmaxf(am, __shfl_xor(am, o));
            const float sc = am > 0.f ? 127.0f / am : 0.f; hsc[j] = am * (1.0f / 127.0f);
#pragma unroll
            for (int w = 0; w < 4; ++w) { const int b0 = (int)rintf(hv[4 * w] * sc), b1 = (int)rintf(hv[4 * w + 1] * sc), b2 = (int)rintf(hv[4 * w + 2] * sc), b3 = (int)rintf(hv[4 * w + 3] * sc);
                hq[j][w] = (int)((unsigned)(b0 & 0xFF) | ((unsigned)(b1 & 0xFF) << 8) | ((unsigned)(b2 & 0xFF) << 16) | ((unsigned)(b3 & 0xFF) << 24)); } }
        int total;
        { unsigned a0[TPW], a1[TPW], gs0[TPW], gs1[TPW]; int rk0[TPW], rk1[TPW];
          cntl[lane] = 0; cntl[64 + lane] = 0;
#pragma unroll
          for (int j = 0; j < TPW; ++j) { const int t = TPW * wave + j;
              a0[j] = ridx[t * 128 + lane]; a1[j] = ridx[t * 128 + 64 + lane];
              gs0[j] = (unsigned)rgate[t * 128 + lane] | ((unsigned)f2bf(USC[a0[j]] * hsc[j]) << 16); gs1[j] = (unsigned)rgate[t * 128 + 64 + lane] | ((unsigned)f2bf(USC[a1[j]] * hsc[j]) << 16);
              const int s0 = (int)(a0[j] >> PSL_SH), s1 = (int)(a1[j] >> PSL_SH);
              rk0[j] = __hip_atomic_fetch_add(cntl + j * 16 + s0, 1, __ATOMIC_RELAXED, __HIP_MEMORY_SCOPE_WAVEFRONT);
              rk1[j] = __hip_atomic_fetch_add(cntl + j * 16 + s1, 1, __ATOMIC_RELAXED, __HIP_MEMORY_SCOPE_WAVEFRONT); }
          const int qa = 2 * lane, qb = 2 * lane + 1, ja = qa & (TPW - 1), jb = qb & (TPW - 1), sa = ((qa >> 3) + rot) & (PSL - 1), sb = ((qb >> 3) + rot) & (PSL - 1);
          const int ca = cntl[ja * 16 + sa], cb = cntl[jb * 16 + sb];
          int ea = ca, eb = cb;
#pragma unroll
          for (int d = 4; d < 64; d <<= 1) { const int va = __shfl_up(ea, d), vb = __shfl_up(eb, d); ea += (lane >= d) ? va : 0; eb += (lane >= d) ? vb : 0; }
          const int Sa = ea - ca, Sb = eb - cb, c0a = (Sa + GSM) >> GS_LOG, c0b = (Sb + GSM) >> GS_LOG, ga = ((ea + GSM) >> GS_LOG) - c0a, gb = ((eb + GSM) >> GS_LOG) - c0b;
          int incl = ga + gb;
#pragma unroll
          for (int d = 1; d < 64; d <<= 1) { const int v = __shfl_up(incl, d); incl += (lane >= d) ? v : 0; }
          const int Ba = incl - ga - gb, Bb = incl - gb;
          int la = ga > 0 ? Ba + ga : 0, lb = gb > 0 ? Bb + gb : 0;
#pragma unroll
          for (int d = 4; d < 64; d <<= 1) { const int va = __shfl_up(la, d), vb = __shfl_up(lb, d); la = (lane >= d && va > la) ? va : la; lb = (lane >= d && vb > lb) ? vb : lb; }
          int pa = __shfl_up(la, 4), pb = __shfl_up(lb, 4); if (lane < 4) { pa = 0; pb = 0; }
          basel[ja * 16 + sa] = Sa | ((Ba - c0a + 64) << 8) | (pa << 20); basel[jb * 16 + sb] = Sb | ((Bb - c0b + 64) << 8) | (pb << 20); gcnt[qa] = ga; gcnt[qb] = gb;
          total = TPW * (128 >> GS_LOG);
#pragma unroll
          for (int j = 0; j < TPW; ++j) { const int s0 = (int)(a0[j] >> PSL_SH), s1 = (int)(a1[j] >> PSL_SH);
              const int w0 = basel[j * 16 + s0], w1 = basel[j * 16 + s1];
              const int S0 = w0 & 0xFF, S1 = w1 & 0xFF, t0 = S0 + rk0[j], t1 = S1 + rk1[j], g0 = t0 >> GS_LOG, g1 = t1 >> GS_LOG;
              const int G0 = (g0 >= ((S0 + GSM) >> GS_LOG)) ? (((w0 >> 8) & 0xFFF) - 64 + g0) : ((w0 >> 20) - 1), G1 = (g1 >= ((S1 + GSM) >> GS_LOG)) ? (((w1 >> 8) & 0xFFF) - 64 + g1) : ((w1 >> 20) - 1);
              const int p0 = G0 * GSZ + (t0 & GSM), p1 = G1 * GSZ + (t1 & GSM);
              const unsigned tg0 = (t0 & GSM) == 0 ? (unsigned)(j & 3) << 14 : (t0 & GSM) == 1 ? (unsigned)(j >> 2) << 14 : 0u, tg1 = (t1 & GSM) == 0 ? (unsigned)(j & 3) << 14 : (t1 & GSM) == 1 ? (unsigned)(j >> 2) << 14 : 0u;
              sidx[p0] = (unsigned short)(a0[j] | tg0); sgs[p0] = gs0[j]; sidx[p1] = (unsigned short)(a1[j] | tg1); sgs[p1] = gs1[j]; }
        }
        __syncthreads();
#pragma unroll
        for (int j = 0; j < TPW; ++j) *(LAS u32x4*)(L + ((j & 4) ? PS_HQB : 0) + wave * 4096 + (j & 3) * 1024 + lane * 16) = (u32x4){(unsigned)hq[j][0], (unsigned)hq[j][1], (unsigned)hq[j][2], (unsigned)hq[j][3]};
        f32x2 acc2[TPW][8];
#pragma unroll
        for (int j = 0; j < TPW; ++j)
#pragma unroll
            for (int q = 0; q < 8; ++q) acc2[j][q] = (f32x2){0.f, 0.f};
        const LAS unsigned* sidw = (const LAS unsigned*)sidx;
        const int lo16 = lane * 16;
        const __amdgpu_buffer_rsrc_t ursrc = __builtin_amdgcn_make_buffer_rsrc((void*)U8, 0, 16777216, 0x00020000), vrsrc = __builtin_amdgcn_make_buffer_rsrc((void*)V8, 0, 16777216, 0x00020000);
#define PE_LDU(ro) __builtin_bit_cast(u32x4, __builtin_amdgcn_raw_buffer_load_b128(ursrc, lo16, (int)(ro), PE_AUX))
#define PE_LDV(ro) __builtin_bit_cast(u32x4, __builtin_amdgcn_raw_buffer_load_b128(vrsrc, lo16, (int)(ro), PE_AUX))
#define PE_ROWS(w0, w1) const unsigned r0 = ((w0) & 0x3FFFu) << 10, r1 = (((w0) >> 16) & 0x3FFFu) << 10, r2 = ((w1) & 0x3FFFu) << 10, r3 = (((w1) >> 16) & 0x3FFFu) << 10
#define PE_HQ(w0) (*(const LAS u32x4*)(L + ((((w0) >> 30) & 1u) ? PS_HQB : 0) + wave * 4096 + (int)(((w0) >> 14) & 3u) * 1024 + lo16))
        const int lq = lane >> 4;
#if GS_LOG == 3
#define PE_ROWS8(w) const unsigned r0 = (w[0] & 0x3FFFu) << 10, r1 = ((w[0] >> 16) & 0x3FFFu) << 10, r2 = (w[1] & 0x3FFFu) << 10, r3 = ((w[1] >> 16) & 0x3FFFu) << 10, \
                                   r4 = (w[2] & 0x3FFFu) << 10, r5 = ((w[2] >> 16) & 0x3FFFu) << 10, r6 = (w[3] & 0x3FFFu) << 10, r7 = ((w[3] >> 16) & 0x3FFFu) << 10
#define PE_LDU8 { nu[0] = PE_LDU(r0); nu[1] = PE_LDU(r1); nu[2] = PE_LDU(r2); nu[3] = PE_LDU(r3); nu[4] = PE_LDU(r4); nu[5] = PE_LDU(r5); nu[6] = PE_LDU(r6); nu[7] = PE_LDU(r7); }
#define PE_LDV8 { nv[0] = PE_LDV(r0); nv[1] = PE_LDV(r1); nv[2] = PE_LDV(r2); nv[3] = PE_LDV(r3); nv[4] = PE_LDV(r4); nv[5] = PE_LDV(r5); nv[6] = PE_LDV(r6); nv[7] = PE_LDV(r7); }
        u32x4 nu[8], nv[8]; float cfA, cfB; unsigned wa[4];
        { unsigned w[4];
#pragma unroll
          for (int k = 0; k < 4; ++k) w[k] = (unsigned)__builtin_amdgcn_readfirstlane((int)sidw[k]);
          { PE_ROWS8(w); PE_LDU8 PE_LDV8 }
          const u32x4 hqv = PE_HQ(w[0]);
          cfA = peer_gelu(peer_rowsum(peer_dots(nu[0], nu[1], nu[2], nu[3], hqv)), sgs[lq]); cfB = peer_gelu(peer_rowsum(peer_dots(nu[4], nu[5], nu[6], nu[7], hqv)), sgs[4 + lq]);
#pragma unroll
          for (int k = 0; k < 4; ++k) wa[k] = (unsigned)__builtin_amdgcn_readfirstlane((int)sidw[4 + k]);
          { PE_ROWS8(wa); PE_LDU8 } }
        int gi = 0;
#pragma unroll 1
        for (int r = 0; r < PSL; ++r) {
#pragma unroll
            for (int j = 0; j < TPW; ++j) {
                const int cg = __builtin_amdgcn_readfirstlane(gcnt[r * TPW + j]);
#pragma unroll 1
                for (int g = 0; g < cg; ++g) {
                    unsigned wb[4] = {0u, 0u, 0u, 0u};
                    if (gi + 2 < total) {
#pragma unroll
                        for (int k = 0; k < 4; ++k) wb[k] = (unsigned)__builtin_amdgcn_readfirstlane((int)sidw[(gi + 2) * 4 + k]); }
                    const int gn = gi + 1 < total ? gi + 1 : gi;
                    const unsigned mygsA = sgs[gn * 8 + lq], mygsB = sgs[gn * 8 + 4 + lq];
                    const u32x4 hqv = PE_HQ(wa[0]);
                    int kkA = peer_dots(nu[0], nu[1], nu[2], nu[3], hqv), kkB = peer_dots(nu[4], nu[5], nu[6], nu[7], hqv);
#define PE_FMA8(cfx, q, row) { const float coef = __uint_as_float(__builtin_amdgcn_readlane(__float_as_uint(cfx), 16 * (q))); const f32x2 c2 = (f32x2){coef, coef}; const u32x4 a = nv[row]; \
                    _Pragma("unroll") for (int w = 0; w < 4; ++w) { const f32x2 lo = __builtin_amdgcn_cvt_pk_f32_fp8((int)a[w], false), hi = __builtin_amdgcn_cvt_pk_f32_fp8((int)a[w], true); \
                        acc2[j][2 * w] = __builtin_elementwise_fma(c2, lo, acc2[j][2 * w]); acc2[j][2 * w + 1] = __builtin_elementwise_fma(c2, hi, acc2[j][2 * w + 1]); } }
                    PE_FMA8(cfA, 0, 0)
                    kkA = peer_rowsum(kkA);
                    PE_FMA8(cfA, 1, 1)
                    kkB = peer_rowsum(kkB);
                    PE_FMA8(cfA, 2, 2)
                    const float cfnA = peer_gelu(kkA, mygsA);
                    PE_FMA8(cfA, 3, 3)
                    PE_FMA8(cfB, 0, 4)
                    const float cfnB = peer_gelu(kkB, mygsB);
                    PE_FMA8(cfB, 1, 5)
                    PE_FMA8(cfB, 2, 6)
                    PE_FMA8(cfB, 3, 7)
                    { PE_ROWS8(wb); PE_LDU8 }
                    { PE_ROWS8(wa); PE_LDV8 }
                    cfA = cfnA; cfB = cfnB;
#pragma unroll
                    for (int k = 0; k < 4; ++k) wa[k] = wb[k];
                    ++gi;
                }
            }
        }
#else
        u32x4 nu[4], nv[4]; float cf; unsigned wa0, wa1;
        { const unsigned w0 = (unsigned)__builtin_amdgcn_readfirstlane((int)sidw[0]), w1 = (unsigned)__builtin_amdgcn_readfirstlane((int)sidw[1]);
          { PE_ROWS(w0, w1);
            nu[0] = PE_LDU(r0); nu[1] = PE_LDU(r1); nu[2] = PE_LDU(r2); nu[3] = PE_LDU(r3);
            nv[0] = PE_LDV(r0); nv[1] = PE_LDV(r1); nv[2] = PE_LDV(r2); nv[3] = PE_LDV(r3); }
          cf = peer_gelu(peer_rowsum(peer_dots(nu[0], nu[1], nu[2], nu[3], PE_HQ(w0))), sgs[lq]);
          wa0 = (unsigned)__builtin_amdgcn_readfirstlane((int)sidw[2]); wa1 = (unsigned)__builtin_amdgcn_readfirstlane((int)sidw[3]);
          { PE_ROWS(wa0, wa1); nu[0] = PE_LDU(r0); nu[1] = PE_LDU(r1); nu[2] = PE_LDU(r2); nu[3] = PE_LDU(r3); } }
        int gi = 0;
#pragma unroll 1
        for (int r = 0; r < PSL; ++r) {
            const u32x4 gca = *(const LAS u32x4*)(gcnt + r * TPW), gcb = *(const LAS u32x4*)(gcnt + r * TPW + 4);
#pragma unroll
            for (int j = 0; j < TPW; ++j) {
                const int cg = __builtin_amdgcn_readfirstlane((int)(j < 4 ? gca[j & 3] : gcb[j & 3]));
#pragma unroll 1
                for (int g = 0; g < cg; ++g) {
                    const int g2 = gi + 2 < total ? gi + 2 : total - 1;
                    const u32x2 wbv = *(const LAS u32x2*)(sidw + g2 * 2);
                    const int gn = gi + 1 < total ? gi + 1 : gi;
                    const unsigned mygs = sgs[gn * 4 + lq];
                    const float cq[4] = {__uint_as_float(__builtin_amdgcn_readlane(__float_as_uint(cf), 0)), __uint_as_float(__builtin_amdgcn_readlane(__float_as_uint(cf), 16)),
                                         __uint_as_float(__builtin_amdgcn_readlane(__float_as_uint(cf), 32)), __uint_as_float(__builtin_amdgcn_readlane(__float_as_uint(cf), 48))};
                    int kk = peer_dots(nu[0], nu[1], nu[2], nu[3], PE_HQ(wa0));
#define PE_FMA(q) { const float coef = cq[q]; const f32x2 c2 = (f32x2){coef, coef}; const u32x4 a = nv[q]; \
                    _Pragma("unroll") for (int w = 0; w < 4; ++w) { const f32x2 lo = __builtin_amdgcn_cvt_pk_f32_fp8((int)a[w], false), hi = __builtin_amdgcn_cvt_pk_f32_fp8((int)a[w], true); \
                        acc2[j][2 * w] = __builtin_elementwise_fma(c2, lo, acc2[j][2 * w]); acc2[j][2 * w + 1] = __builtin_elementwise_fma(c2, hi, acc2[j][2 * w + 1]); } }
                    __builtin_amdgcn_s_setprio(1);
                    PE_FMA(0)
                    kk = peer_rowsum(kk);
                    PE_FMA(1)
                    const float cfn = peer_gelu(kk, mygs);
                    PE_FMA(2)
                    PE_FMA(3)
                    __builtin_amdgcn_s_setprio(0);
                    const unsigned wb0 = (unsigned)__builtin_amdgcn_readfirstlane((int)wbv[0]), wb1 = (unsigned)__builtin_amdgcn_readfirstlane((int)wbv[1]);
                    { PE_ROWS(wb0, wb1); nu[0] = PE_LDU(r0); nu[1] = PE_LDU(r1); nu[2] = PE_LDU(r2); nu[3] = PE_LDU(r3); }
                    { PE_ROWS(wa0, wa1); nv[0] = PE_LDV(r0); nv[1] = PE_LDV(r1); nv[2] = PE_LDV(r2); nv[3] = PE_LDV(r3); }
                    cf = cfn; wa0 = wb0; wa1 = wb1;
                    ++gi;
                }
            }
        }
#endif
#pragma unroll
        for (int j = 0; j < TPW; ++j) { const size_t tok = (size_t)tb * (8 * TPW) + TPW * wave + j;
            const bf16_t* xr = X1 + tok * 1024 + lane * 16; const float* g2 = mod + (size_t)(tok >> 12) * 6144 + 5120 + lane * 16; const float* fg = p.in[3] + lane * 16;
            const u32x4 xa = *(const u32x4*)xr, xb = *(const u32x4*)(xr + 8);
            float y[16]; float ss = 0.f;
#pragma unroll
            for (int q = 0; q < 4; ++q) { const unsigned w0 = (q < 2 ? xa : xb)[2 * (q & 1)], w1 = (q < 2 ? xa : xb)[2 * (q & 1) + 1];
                const f32x4 xv = (f32x4){blo(w0), bhi(w0), blo(w1), bhi(w1)}, gv = *(const f32x4*)(g2 + 4 * q);
#pragma unroll
                for (int c = 0; c < 4; ++c) { const float yy = xv[c] + gv[c] * acc2[j][q * 2 + (c >> 1)][c & 1]; y[q * 4 + c] = yy; ss += yy * yy; } }
            ss = wave_sum(ss); const float rstd = rsqrtf(ss * (1.0f / 1024.0f) + 1e-6f);
#pragma unroll
            for (int q = 0; q < 4; ++q) { const f32x4 fv = *(const f32x4*)(fg + 4 * q);
                f32x4 o; o[0] = y[q * 4] * rstd * fv[0]; o[1] = y[q * 4 + 1] * rstd * fv[1]; o[2] = y[q * 4 + 2] * rstd * fv[2]; o[3] = y[q * 4 + 3] * rstd * fv[3];
                *(f32x4*)(p.out + tok * 1024 + lane * 16 + 4 * q) = o; } }
        __syncthreads();
    }
}
#ifndef MK_REP
#define MK_REP 0
#endif
DI void run_p2(const Params& p, LAS unsigned char* L, int bid, int nb) { unsigned char* ws = p.ws; unsigned char* outb = (unsigned char*)p.out;
    pg8::Gemm g; g.A = (const bf16_t*)(outb + OUT_H1); g.Bt = (const bf16_t*)(ws + OFF_WIN); g.M = NTOK; g.N = NGEMM; g.K = 1024;
    pg8::StaticOrder S; S.init(g.M, g.N, nb, bid); pg8::EpiInproj E; E.O = (bf16_t*)(ws + OFF_P); E.ldc = NP; E.GT = (bf16_t*)(ws + OFF_GATES);
    pg8::gemm_phase<pg8::EpiInproj, pg8::StaticOrder, false>(L, g, S, E, nullptr); }
DI void run_p3(const Params& p, LAS unsigned char* L, int bid, int nb) {
#ifndef NO_P3A
    dn_prep(p, L, bid, nb);
#if (MK_REP >> 13) & 1
    dn_prep(p, L, bid, nb);
#endif
#endif
#ifndef NO_P3B
    for (int t = bid; t < 256; t += nb) compress_task(p, L, t);
#if (MK_REP >> 14) & 1
    for (int t = bid; t < 256; t += nb) compress_task(p, L, t);
#endif
#endif
#ifndef NO_P3C
    for (int u = bid; u < 512; u += nb) vtrans_unit(p, L, 4 * u);
#if (MK_REP >> 15) & 1
    for (int u = bid; u < 512; u += nb) vtrans_unit(p, L, 4 * u);
#endif
#endif
}
DI void run_p4(const Params& p, LAS unsigned char* lds, LAS unsigned char* L, int bid, int nb, int it) { const int tid = threadIdx.x;
#ifndef NO_P4A
    for (int bp = bid; bp < 32; bp += nb) dn_scan<2>(p, L, 2 * bp);
#if (MK_REP >> 11) & 1
    for (int bp = bid; bp < 32; bp += nb) dn_scan<2>(p, L, 2 * bp);
#endif
#endif
    LAS int* slot = (LAS int*)(lds + 32);
    { unsigned* ctr = (unsigned*)(p.ws + OFF_CTR) + (it * 8) * 64; const int x0 = (int)(xb_xcc_id() & 7u);
      for (int qi = 0; qi < 8; ++qi) { const int x = (x0 + qi) & 7;
        for (;;) { if (tid == 0) *slot = (int)atomicAdd(ctr + x * 64, 1u); __syncthreads(); const int n = *slot; __syncthreads(); if (n >= 128) break;
#ifndef NO_P4B
            attn_unit(p, L, ((n >> 1) << 4) | (2 * x + (n & 1)));
#endif
        } } }
#if (MK_REP >> 12) & 1
    { unsigned* ctr = (unsigned*)(p.ws + OFF_CTR) + 1000 + it * 8;
    for (;;) { if (tid == 0) *slot = (int)atomicAdd(ctr, 1u); __syncthreads(); const int u = *slot; __syncthreads(); if (u >= 1024) break;
        attn_unit(p, L, u);
    } }
#endif
}
DI void run_p5(const Params& p, LAS unsigned char* L, int bid, int nb) { unsigned char* ws = p.ws; unsigned char* outb = (unsigned char*)p.out;
    static_assert(OUT_ODN == OUT_ONSA + (size_t)NTOK * 512 * 2 && OFF_WD == OFF_WN + (size_t)1024 * 512 * 2, "the pair GEMM needs its operands stacked");
    pg8::Gemm g; g.A = (const bf16_t*)(outb + OUT_ONSA); g.Bt = (const bf16_t*)(ws + OFF_WN); g.M = NTOK; g.N = 1024; g.K = 512;
    pg8::PairOrder S; S.init(g.M, g.N, nb, bid);
    pg8::EpiGateFrag E; E.O = (bf16_t*)(outb + OUT_MRG); E.ldc = 1024; E.GT = (const bf16_t*)(ws + OFF_GATES); E.nM = NTOK / 256; E.nN = 4;
    pg8::gemm_phase<pg8::EpiGateFrag, pg8::PairOrder, false>(L, g, S, E, nullptr); }
DI void run_p7(const Params& p, LAS unsigned char* L, int bid, int nb) { unsigned char* ws = p.ws; unsigned char* outb = (unsigned char*)p.out;
    pg8::Gemm g; g.A = (const bf16_t*)(outb + OUT_MRG); g.Bt = (const bf16_t*)(ws + OFF_WO); g.M = NTOK; g.N = 1024; g.K = 1024;
    pg8::StaticOrder S; S.init(g.M, g.N, nb, bid); pg8::EpiResid E; E.X = p.in[0]; E.O = (bf16_t*)(ws + OFF_X1); E.mod = (const float*)(ws + OFF_MOD); E.goff = 2048;
    pg8::gemm_phase<pg8::EpiResid, pg8::StaticOrder, false>(L, g, S, E, nullptr); }
DI void run_p8(const Params& p, int bid, int nb) { unsigned char* ws = p.ws;
    norm_rows<true>((const void*)(ws + OFF_X1), p.in[20], (const float*)(ws + OFF_MOD), 3072, 4096, (bf16_t*)(ws + OFF_H2), bid, nb);
    cvt_i8_rows(p.in[24], ws + OFF_UBF, (float*)(ws + OFF_USC), 16384, bid, nb); cvt_fp8(p.in[25], ws + OFF_VBF, (size_t)16384 * 1024, 1.0f, bid, nb); }
DI void run_p9(const Params& p, LAS unsigned char* L, int bid, int nb) { unsigned char* ws = p.ws;
    pg8::Gemm g; g.A = (const bf16_t*)(ws + OFF_H2); g.Bt = (const bf16_t*)(ws + OFF_WQ); g.M = NTOK; g.N = 1024; g.K = 1024;
    pg8::StaticOrder S; S.init(g.M, g.N, nb, bid); pg8::EpiStore16 E; E.O = (bf16_t*)(ws + OFF_QRY); E.ldc = 1024;
    pg8::gemm_phase<pg8::EpiStore16, pg8::StaticOrder, false>(L, g, S, E, nullptr); }
#define REPEAT(k, call) { call; if (MK_REP & (1 << (k))) { call; } }
__global__ void __launch_bounds__(512, 2) mk_fwd(Params p, int lo, int hi) {
    extern __shared__ __attribute__((aligned(16))) unsigned char shm[];
    LAS unsigned char* lds = (LAS unsigned char*)shm;
    LAS unsigned char* L = lds + LDS_USER;
    const int bid = blockIdx.x, nb = gridDim.x, tid = threadIdx.x;
    unsigned char* ws = p.ws;
    const bool fused = (hi - lo) > 1;
    XcdBarrier bar; bar.bar = (unsigned*)ws; bar.x = 0; bar.st = (volatile LAS unsigned*)lds;
    if (fused) { if (tid == 0) { *(LAS u32x4*)lds = (u32x4){0u, 0u, 0u, 0u}; } __syncthreads(); bar = xcd_barrier_post((unsigned*)ws, (volatile LAS unsigned*)lds); }
    const float* mod = (const float*)(ws + OFF_MOD);
    unsigned char* outb = (unsigned char*)p.out;
#ifdef ONLY_PHASE
#define PHASE(k) if ((k) == ONLY_PHASE && lo <= (k) && (k) < hi)
#else
#define PHASE(k) if (lo <= (k) && (k) < hi)
#endif
#define SEAM(k) if (fused && lo <= (k) && (k) + 1 < hi) xcd_barrier(bar);
    PHASE(0) REPEAT(0, phase_prologue(p, L, bid, nb))
    SEAM(0)
    PHASE(1) REPEAT(1, norm_rows<false>(p.in[0], p.in[6], mod, 0, 1024, (bf16_t*)(outb + OUT_H1), bid, nb))
    SEAM(1)
    PHASE(2) REPEAT(2, run_p2(p, L, bid, nb))
    SEAM(2)
    PHASE(3) REPEAT(3, run_p3(p, L, bid, nb))
    SEAM(3)
    PHASE(4) { run_p4(p, lds, L, bid, nb, 0); if (MK_REP & (1 << 4)) { run_p4(p, lds, L, bid, nb, 1); } }
    SEAM(4)
    PHASE(5) REPEAT(5, run_p5(p, L, bid, nb))
    SEAM(5)
    PHASE(7) REPEAT(7, run_p7(p, L, bid, nb))
    SEAM(7)
    PHASE(8) REPEAT(8, run_p8(p, bid, nb))
    SEAM(8)
    PHASE(9) REPEAT(9, run_p9(p, L, bid, nb))
    SEAM(9)
    PHASE(10) REPEAT(10, peer_phase(p, L, bid, nb))
#undef PHASE
#undef SEAM
}
constexpr int N_PHASES = 11;
#ifndef MK_ONE_LAUNCH
#define MK_ONE_LAUNCH 1
#endif
extern "C" void kernel_launch(void* const* d_in, const int* in_sizes, int n_in, void* d_out, int out_size, void* d_ws, size_t ws_size, hipStream_t stream) {
    (void)in_sizes; (void)n_in; (void)out_size;
    static int grid = 0;
    if (!grid) {
        int dev = 0, cus = 0, per_cu = 0; hipGetDevice(&dev); hipDeviceGetAttribute(&cus, hipDeviceAttributeMultiprocessorCount, dev);
        hipFuncSetAttribute((const void*)mk_fwd, hipFuncAttributeMaxDynamicSharedMemorySize, LDS_BYTES);
        hipOccupancyMaxActiveBlocksPerMultiprocessor(&per_cu, (const void*)mk_fwd, 512, LDS_BYTES);
        if (per_cu < 1) { fprintf(stderr, "mk_fwd: occupancy query says 0 blocks per CU\n"); per_cu = 1; }
        grid = cus;
        if (ws_size < WS_NEED) fprintf(stderr, "mk_fwd: workspace too small (%zu < %zu)\n", ws_size, (size_t)WS_NEED);
    }
    hipMemsetAsync(d_ws, 0, 20480, stream);
    Params p{}; for (int i = 0; i < 26; ++i) p.in[i] = (const float*)d_in[i]; p.out = (float*)d_out; p.ws = (unsigned char*)d_ws;
#if MK_ONE_LAUNCH
    hipLaunchKernelGGL(mk_fwd, dim3(grid), dim3(512), LDS_BYTES, stream, p, 0, N_PHASES);
#else
    for (int k = 0; k < N_PHASES; ++k) hipLaunchKernelGGL(mk_fwd, dim3(grid), dim3(512), LDS_BYTES, stream, p, k, k + 1);
#endif
}
```
